# Optimizing an MI355X kernel written in HIP

```python
import math
import jax, jax.numpy as jnp
from jax import lax
import numpy as np

D_MODEL = 4096
BATCH = 4
SEQ = 4096
DEPTH = 1

HEAD_DIM = 128
N_HEADS = D_MODEL // HEAD_DIM
HEADS_A = N_HEADS // 2
HEADS_B = N_HEADS - HEADS_A
WIDTH_A = HEADS_A * HEAD_DIM
WIDTH_B = HEADS_B * HEAD_DIM
MIX_WIDTH = WIDTH_A + WIDTH_B
DILATED_BRANCHES = ((128, 1), (512, 4), (2048, 16))
BLOCK_Q = 128
NUM_BUCKETS = 32
MAX_DISTANCE = 2048
FGATE_BIAS_MEAN = 2.0
PEER_HEADS = 8
N_KEYS = 128
N_EXPERTS = N_KEYS * N_KEYS
PEER_TOPK = 16
PEER_QUERY_DIM = 256
PEER_HALF = PEER_QUERY_DIM // 2
PEER_CHUNK = 64
N_MOD = 6
NORM_EPS = 1e-6
NEG_INF = -1e30
IN_COLS = 3 * WIDTH_A + 3 * WIDTH_B + HEADS_B

kernel_name = 'hybrid_dilated_fox_peer_layer'


def rmsnorm(x, g):
    x32 = x.astype(jnp.float32)
    y = x32 * lax.rsqrt(jnp.mean(x32 * x32, axis=-1, keepdims=True) + NORM_EPS)
    return (y * g.astype(jnp.float32)).astype(x.dtype)


def t5_bucket(dist):
    max_exact = NUM_BUCKETS // 2
    d32 = jnp.maximum(dist, 1).astype(jnp.float32)
    large = max_exact + (jnp.log(d32 / max_exact) / math.log(MAX_DISTANCE / max_exact)
                         * (NUM_BUCKETS - max_exact)).astype(jnp.int32)
    large = jnp.minimum(large, NUM_BUCKETS - 1)
    return jnp.where(dist < max_exact, dist, large)


def dilated_branch(q, k, v, rel_bias, window, dilation):
    B, H, S, Dh = q.shape
    L = S // dilation
    nw = window // dilation
    bq = min(BLOCK_Q, L)
    nblk = L // bq

    def to_sub(t):
        return t.reshape(B, H, L, dilation, Dh).transpose(0, 1, 3, 2, 4)

    qs = to_sub(q).reshape(B, H, dilation, nblk, bq, Dh)
    pad = ((0, 0), (0, 0), (0, 0), (nw, 0), (0, 0))
    ks = jnp.pad(to_sub(k), pad)
    vs = jnp.pad(to_sub(v), pad)
    idx = jnp.arange(nblk)[:, None] * bq + jnp.arange(bq + nw)[None, :]
    kb = ks[:, :, :, idx]
    vb = vs[:, :, :, idx].astype(jnp.float32)
    logits = jnp.einsum('bhrnid,bhrnjd->bhrnij', qs, kb).astype(jnp.float32) * (HEAD_DIM ** -0.5)
    rel = jnp.arange(bq)[:, None] + nw - jnp.arange(bq + nw)[None, :]
    in_win = (rel >= 0) & (rel <= nw)
    bucket = t5_bucket(jnp.clip(rel, 0, nw) * dilation)
    bias = jnp.transpose(rel_bias[bucket], (2, 0, 1)).astype(jnp.float32)
    key_ok = (idx - nw) >= 0
    mask = in_win[None, :, :] & key_ok[:, None, :]
    logits = jnp.where(mask, logits + bias[:, None, None], NEG_INF)
    m = jnp.max(logits, axis=-1, keepdims=True)
    p = jnp.exp(logits - m)
    denom = jnp.sum(p, axis=-1, keepdims=True)
    num = jnp.einsum('bhrnij,bhrnjd->bhrnid', p, vb)

    def from_sub(t):
        return t.reshape(B, H, dilation, L, -1).transpose(0, 1, 3, 2, 4).reshape(B, H, S, -1)

    return from_sub(num), from_sub(m), from_sub(denom)


def dilated_attention(q, k, v, rel_bias):
    outs = [dilated_branch(q, k, v, rel_bias, w, d) for (w, d) in DILATED_BRANCHES]
    m_all = outs[0][1]
    for o in outs[1:]:
        m_all = jnp.maximum(m_all, o[1])
    num = outs[0][0] * jnp.exp(outs[0][1] - m_all)
    den = outs[0][2] * jnp.exp(outs[0][1] - m_all)
    for o in outs[1:]:
        w = jnp.exp(o[1] - m_all)
        num = num + o[0] * w
        den = den + o[2] * w
    return num / den


def forgetting_attention(q, k, v, log_f):
    B, H, S, Dh = q.shape
    nq = S // BLOCK_Q
    F = jnp.cumsum(log_f, axis=-1)
    k32 = k.astype(jnp.float32)
    v32 = v.astype(jnp.float32)
    qb = q.astype(jnp.float32).reshape(B, H, nq, BLOCK_Q, Dh).transpose(2, 0, 1, 3, 4)
    Fq = F.reshape(B, H, nq, BLOCK_Q).transpose(2, 0, 1, 3)
    starts = jnp.arange(nq, dtype=jnp.int32) * BLOCK_Q
    kpos = jnp.arange(S, dtype=jnp.int32)
    scale = HEAD_DIM ** -0.5

    def block(args):
        qi, Fi, s0 = args
        logits = jnp.einsum('bhid,bhjd->bhij', qi, k32) * scale + Fi[..., :, None] - F[..., None, :]
        causal = kpos[None, :] <= (s0 + jnp.arange(BLOCK_Q, dtype=jnp.int32))[:, None]
        p = jax.nn.softmax(jnp.where(causal, logits, NEG_INF), axis=-1)
        return jnp.einsum('bhij,bhjd->bhid', p, v32)

    out = lax.map(block, (qb, Fq, starts))
    return out.transpose(1, 2, 0, 3, 4).reshape(B, H, S, Dh)


def peer(h, w_pq, sk1, sk2, expert_u, expert_v):
    B, S, D = h.shape
    T = B * S
    ht = h.reshape(T, D)
    q = jnp.dot(ht, w_pq).reshape(T, PEER_HEADS, 2, PEER_HALF)
    s1 = jnp.einsum('thd,kd->thk', q[:, :, 0], sk1).astype(jnp.float32)
    s2 = jnp.einsum('thd,kd->thk', q[:, :, 1], sk2).astype(jnp.float32)
    v1, i1 = lax.top_k(s1, PEER_TOPK)
    v2, i2 = lax.top_k(s2, PEER_TOPK)
    cand = (v1[..., :, None] + v2[..., None, :]).reshape(T, PEER_HEADS, PEER_TOPK * PEER_TOPK)
    vs, ci = lax.top_k(cand, PEER_TOPK)
    e1 = jnp.take_along_axis(i1, ci // PEER_TOPK, axis=-1)
    e2 = jnp.take_along_axis(i2, ci % PEER_TOPK, axis=-1)
    eid = (e1 * N_KEYS + e2).reshape(T, PEER_HEADS * PEER_TOPK)
    gate = jax.nn.softmax(vs, axis=-1).reshape(T, PEER_HEADS * PEER_TOPK)
    nch = T // PEER_CHUNK

    def chunk(args):
        hc, ec, gc = args
        a = jnp.einsum('ced,cd->ce', expert_u[ec], hc).astype(jnp.float32)
        act = jax.nn.gelu(a, approximate=False) * gc
        return jnp.einsum('ce,ced->cd', act, expert_v[ec].astype(jnp.float32))

    y = lax.map(chunk, (ht.reshape(nch, PEER_CHUNK, D),
                        eid.reshape(nch, PEER_CHUNK, -1),
                        gate.reshape(nch, PEER_CHUNK, -1)))
    return y.reshape(B, S, D).astype(h.dtype)


def hybrid_layer(x, c, w_ada, b_ada, norm1_g, w_in, b_f, q_norm_a, k_norm_a, q_norm_b, k_norm_b,
                 rel_bias, w_o, norm2_g, w_pq, sub_keys_1, sub_keys_2, expert_u, expert_v):
    B, S, D = x.shape
    mod = jnp.dot(jax.nn.silu(c), w_ada) + b_ada
    sh1, sc1, g1, sh2, sc2, g2 = jnp.split(mod[:, None, :], N_MOD, axis=-1)

    h = rmsnorm(x, norm1_g) * (1.0 + sc1) + sh1
    proj = jnp.dot(h, w_in)
    bounds = [WIDTH_A, 2 * WIDTH_A, 3 * WIDTH_A, 3 * WIDTH_A + WIDTH_B,
              3 * WIDTH_A + 2 * WIDTH_B, 3 * WIDTH_A + 3 * WIDTH_B]
    qa, ka, va, qb, kb, vb, fz = jnp.split(proj, bounds, axis=-1)

    def heads(t, n):
        return t.reshape(B, S, n, HEAD_DIM).transpose(0, 2, 1, 3)

    qa = rmsnorm(heads(qa, HEADS_A), q_norm_a)
    ka = rmsnorm(heads(ka, HEADS_A), k_norm_a)
    va = heads(va, HEADS_A)
    qb = rmsnorm(heads(qb, HEADS_B), q_norm_b)
    kb = rmsnorm(heads(kb, HEADS_B), k_norm_b)
    vb = heads(vb, HEADS_B)
    log_f = jax.nn.log_sigmoid((fz + b_f).astype(jnp.float32)).transpose(0, 2, 1)

    out_a = dilated_attention(qa, ka, va, rel_bias)
    out_b = forgetting_attention(qb, kb, vb, log_f)
    mix = jnp.concatenate([out_a, out_b], axis=1).transpose(0, 2, 1, 3).reshape(B, S, MIX_WIDTH)
    x = x + g1 * jnp.dot(mix.astype(x.dtype), w_o)

    h2 = rmsnorm(x, norm2_g) * (1.0 + sc2) + sh2
    x = x + g2 * peer(h2, w_pq, sub_keys_1, sub_keys_2, expert_u, expert_v)
    return x


def setup_inputs(seed: int = 0) -> dict:
    key = jax.random.key(seed)
    ks = jax.random.split(key, 20)
    f32 = jnp.float32
    dsc = D_MODEL ** -0.5
    nrm = lambda k, shape: jax.random.normal(k, shape, f32)
    return {
        'x': nrm(ks[0], (BATCH, SEQ, D_MODEL)),
        'c': nrm(ks[1], (BATCH, D_MODEL)),
        'w_ada': nrm(ks[2], (DEPTH, D_MODEL, N_MOD * D_MODEL)) * (0.5 * dsc),
        'b_ada': nrm(ks[3], (DEPTH, N_MOD * D_MODEL)) * 0.02,
        'norm1_g': 1.0 + 0.02 * nrm(ks[4], (DEPTH, D_MODEL)),
        'w_in': nrm(ks[5], (DEPTH, D_MODEL, IN_COLS)) * dsc,
        'b_f': FGATE_BIAS_MEAN + 0.1 * nrm(ks[6], (DEPTH, HEADS_B)),
        'q_norm_a': 1.0 + 0.02 * nrm(ks[7], (DEPTH, HEAD_DIM)),
        'k_norm_a': 1.0 + 0.02 * nrm(ks[8], (DEPTH, HEAD_DIM)),
        'q_norm_b': 1.0 + 0.02 * nrm(ks[9], (DEPTH, HEAD_DIM)),
        'k_norm_b': 1.0 + 0.02 * nrm(ks[10], (DEPTH, HEAD_DIM)),
        'rel_bias': 0.5 * nrm(ks[11], (NUM_BUCKETS, HEADS_A)),
        'w_o': nrm(ks[12], (DEPTH, MIX_WIDTH, D_MODEL)) * (MIX_WIDTH ** -0.5),
        'norm2_g': 1.0 + 0.02 * nrm(ks[13], (DEPTH, D_MODEL)),
        'w_pq': nrm(ks[14], (DEPTH, D_MODEL, PEER_HEADS * PEER_QUERY_DIM)) * dsc,
        'sub_keys_1': nrm(ks[15], (DEPTH, N_KEYS, PEER_HALF)) * (PEER_HALF ** -0.5),
        'sub_keys_2': nrm(ks[16], (DEPTH, N_KEYS, PEER_HALF)) * (PEER_HALF ** -0.5),
        'expert_u': nrm(ks[17], (DEPTH, N_EXPERTS, D_MODEL)) * dsc,
        'expert_v': nrm(ks[18], (DEPTH, N_EXPERTS, D_MODEL)) * 0.5,
    }


def reference(x, c, w_ada, b_ada, norm1_g, w_in, b_f, q_norm_a, k_norm_a, q_norm_b, k_norm_b,
              rel_bias, w_o, norm2_g, w_pq, sub_keys_1, sub_keys_2, expert_u, expert_v):
    for l in range(DEPTH):
        x = hybrid_layer(x, c, w_ada[l], b_ada[l], norm1_g[l], w_in[l], b_f[l],
                         q_norm_a[l], k_norm_a[l], q_norm_b[l], k_norm_b[l], rel_bias,
                         w_o[l], norm2_g[l], w_pq[l], sub_keys_1[l], sub_keys_2[l],
                         expert_u[l], expert_v[l])
    return x
```

```cpp
#include <hip/hip_runtime.h>
#include <cstdio>
#include <cstdint>

#define LAS __attribute__((address_space(3)))
typedef unsigned short bf16_t;
typedef short bf16x8 __attribute__((ext_vector_type(8)));
typedef short s16x4 __attribute__((ext_vector_type(4)));
typedef float f32x4 __attribute__((ext_vector_type(4)));
typedef float f32x2 __attribute__((ext_vector_type(2)));
typedef float f32x16 __attribute__((ext_vector_type(16)));
typedef unsigned u32x4 __attribute__((ext_vector_type(4)));
typedef unsigned u32x2 __attribute__((ext_vector_type(2)));
typedef int i32x8 __attribute__((ext_vector_type(8)));
typedef int i32x4 __attribute__((ext_vector_type(4)));
typedef int i32x2 __attribute__((ext_vector_type(2)));
typedef int i32x6 __attribute__((ext_vector_type(6)));
typedef unsigned u32x16 __attribute__((ext_vector_type(16)));
typedef __bf16 bf16x32 __attribute__((ext_vector_type(32)));

constexpr int DM = 4096, NBATCH = 4, SEQ = 4096, NTOK = NBATCH * SEQ, HD = 128, NHA = 16, NHB = 16;
constexpr int NQKV = 12288, INC = 12304, NMOD = 6 * DM;
constexpr int PHEADS = 8, NKEYS = 128, NEXP = 16384, TOPK = 16, NSC = PHEADS * 2 * NKEYS;
constexpr float NORM_EPS = 1e-6f;
constexpr int NTHREADS = 512;
constexpr int LDS_RING = 131072, LDS_AUX = 131072, LDS_BYTES = 163840;
constexpr int LDS_BARW = LDS_BYTES - 64;

constexpr size_t WS_CTL = 0;
constexpr size_t WS_MOD = 65536;
constexpr size_t WS_LOGF = WS_MOD + 393216;
constexpr size_t WS_NB = WS_LOGF + 1048576;
constexpr size_t WS_WFZT = WS_NB + 1048576;
constexpr size_t WS_GTAB = WS_WFZT + 131072;
constexpr size_t WS_H = 4194304;
constexpr size_t WS_WINT = WS_H + 134217728;
constexpr size_t WS_WOT = WS_WINT + 100663296;
constexpr size_t WS_WCT = WS_WOT + 33554432;
constexpr size_t WS_UB = WS_WCT + 16777216;
constexpr size_t WS_VT = WS_UB + 134217728;
constexpr size_t WS_QKV = WS_VT + 134217728;
constexpr size_t WS_SC = WS_QKV + 536870912;
constexpr size_t WS_H8 = WS_SC + 134217728;
constexpr size_t WS_X1 = WS_H8 + 67108864;
constexpr size_t WS_PRE = WS_X1 + 134217728;
constexpr size_t WS_GATEC = WS_PRE + 8388608;
constexpr size_t WS_EC = WS_GATEC + 8388608;
constexpr size_t WS_END = WS_EC + 8388608;
constexpr size_t CTL_ZERO_BYTES = 65536;

struct Args { const float* in[19]; float* out; unsigned char* ws; int ph_lo, ph_hi, bar_idx, pad; };
__device__ __forceinline__ int lane_fresh() { int z = 0; asm volatile("" : "+s"(z)); return (int)__builtin_amdgcn_mbcnt_hi(~0u, __builtin_amdgcn_mbcnt_lo(~0u, (unsigned)z)); }
#define TIDX (wv_ * 64 + lane_fresh())
typedef const __attribute__((address_space(4))) unsigned char* KargP;
__device__ __forceinline__ const float* karg_in(int k) {
    KargP p = (KargP)__builtin_amdgcn_kernarg_segment_ptr(); asm volatile("" : "+s"(p));
    return *(const float* const __attribute__((address_space(4)))*)(p + 8 * k);
}

__device__ __forceinline__ unsigned cvt_pk_bf16(float lo, float hi) { unsigned r; asm volatile("v_cvt_pk_bf16_f32 %0, %1, %2" : "=v"(r) : "v"(lo), "v"(hi)); return r; }
__device__ __forceinline__ u32x2 pack8_fp8(f32x4 a, f32x4 b) { int w0 = __builtin_amdgcn_cvt_pk_fp8_f32(a[0], a[1], 0, false); w0 = __builtin_amdgcn_cvt_pk_fp8_f32(a[2], a[3], w0, true);
    int w1 = __builtin_amdgcn_cvt_pk_fp8_f32(b[0], b[1], 0, false); w1 = __builtin_amdgcn_cvt_pk_fp8_f32(b[2], b[3], w1, true); u32x2 r; r.x = (unsigned)w0; r.y = (unsigned)w1; return r; }
__device__ __forceinline__ void store_fp6_slot(unsigned char* ktile_row, int g, i32x6 pk) {
    *(i32x4*)(ktile_row + 16 * g) = (i32x4){pk[0], pk[1], pk[2], pk[3]}; *(i32x2*)(ktile_row + 64 + 16 * g) = (i32x2){pk[4], pk[5]}; }
__device__ __forceinline__ float bf2f(bf16_t b) { return __uint_as_float(((unsigned)b) << 16); }
__device__ __forceinline__ bf16_t f2bf(float f) { return (bf16_t)(cvt_pk_bf16(f, 0.f) & 0xffffu); }

#define XB_TMO      128
#define XB_XCNT(j)  (256  + 64 * (j))
#define XB_XSUB(j)  (1280 + 64 * (j))
#define XB_XGEN(j)  (2304 + 64 * (j))
#define XB_TOP      3328
#define XB_TOPGEN   3392
#define XCD_BAR_WORDS 3456
#define XB_SPIN_CAP (1u << 22)

__device__ __forceinline__ unsigned xb_ld(unsigned* p)              { return __hip_atomic_load(p, __ATOMIC_RELAXED, __HIP_MEMORY_SCOPE_AGENT); }
__device__ __forceinline__ unsigned xb_add(unsigned* p, unsigned v) { return __hip_atomic_fetch_add(p, v, __ATOMIC_RELAXED, __HIP_MEMORY_SCOPE_AGENT); }
__device__ __forceinline__ unsigned xb_xcc_id() { return (unsigned)__builtin_amdgcn_s_getreg((3 << 11) | 20) & 0xFu; }
#define XB_SPIN(cond, bar) do { unsigned _sp = 0; while (cond) { __builtin_amdgcn_s_sleep(1); \
    if ((++_sp & 255u) == 0u) { if (xb_ld(&(bar)[XB_TMO])) break; if (_sp > XB_SPIN_CAP) { atomicAdd(&(bar)[XB_TMO], 1u); break; } } } } while (0)

struct XcdBarrier { unsigned* bar; unsigned x; volatile LAS unsigned* st; };

__device__ __forceinline__ XcdBarrier xcd_barrier_post(unsigned* bar, volatile LAS unsigned* st, int wv_) {
    XcdBarrier b; b.bar = bar; b.x = xb_xcc_id(); b.st = st;
    if (wv_ == 0 && lane_fresh() == 0) (void)xb_add(&bar[XB_XCNT(b.x)], 1u);
    return b;
}
__device__ __forceinline__ void xcd_barrier_complete(unsigned* bar, unsigned x, unsigned& nloc, unsigned& nx) {
    const unsigned G = gridDim.x * gridDim.y * gridDim.z;
    unsigned sum, cnt, mine, sp = 0u;
    for (;;) {
        sum = 0u; cnt = 0u; mine = 0u;
#pragma unroll
        for (unsigned j = 0; j < 16; ++j) { const unsigned c = xb_ld(&bar[XB_XCNT(j)]); sum += c; cnt += (c > 0u) ? 1u : 0u; mine = (j == x) ? c : mine; }
        if (sum == G) break;
        __builtin_amdgcn_s_sleep(1);
        if ((++sp & 255u) == 0u) { if (xb_ld(&bar[XB_TMO])) break; if (sp > XB_SPIN_CAP) { atomicAdd(&bar[XB_TMO], 1u); break; } }
    }
    nloc = mine > 0u ? mine : 1u; nx = cnt > 0u ? cnt : 1u;
}
__device__ __forceinline__ void xcd_barrier(const XcdBarrier& b, int wv_) {
    asm volatile("s_waitcnt vmcnt(0)" ::: "memory");
    __syncthreads();
    if (wv_ == 0 && lane_fresh() == 0) {
        unsigned* bar = b.bar;
        __builtin_amdgcn_s_waitcnt(0);
        unsigned nloc = b.st[0], nx = b.st[1];
        if (nloc == 0u) { xcd_barrier_complete(bar, b.x, nloc, nx); b.st[0] = nloc; b.st[1] = nx; }
        const unsigned old = xb_add(&bar[XB_XSUB(b.x)], 1u);
        const unsigned gen = old / nloc;
        if (old + 1u == (gen + 1u) * nloc) {
            __builtin_amdgcn_fence(__ATOMIC_RELEASE, "agent");
            asm volatile("s_waitcnt vmcnt(0)" ::: "memory");
            const unsigned og = xb_add(&bar[XB_TOP], 1u);
            const unsigned tg = og / nx;
            if (og + 1u == (tg + 1u) * nx) xb_add(&bar[XB_TOPGEN], 1u);
            else XB_SPIN(xb_ld(&bar[XB_TOPGEN]) == tg, bar);
            __builtin_amdgcn_fence(__ATOMIC_ACQUIRE, "agent");
            xb_add(&bar[XB_XGEN(b.x)], 1u);
            asm volatile("s_waitcnt vmcnt(0)" ::: "memory");
        } else {
            XB_SPIN(xb_ld(&bar[XB_XGEN(b.x)]) == gen, bar);
            __builtin_amdgcn_fence(__ATOMIC_ACQUIRE, "agent");
            asm volatile("s_waitcnt vmcnt(0)" ::: "memory");
        }
    }
    __syncthreads();
}

namespace pg8 {
constexpr int BM = 256, BK = 64, HALF = 128, HTB = HALF * BK * 2, STAGE_BYTES = 8 * HTB, NXCD = 8, WGM = 4;
__host__ __device__ __forceinline__ int lds_byte(int r, int c) { const int st = (r >> 4) * 2 + (c >> 5), rr = r & 15, cc = c & 31, ob = rr * 64 + cc * 2; return st * 1024 + (ob ^ (((ob >> 9) & 1) << 5)); }
__host__ __device__ __forceinline__ void stage_rc(int b, int& R, int& C) { const int st = b / 1024, sb = b % 1024, swz = sb ^ (((sb >> 9) & 1) << 5); R = (st >> 1) * 16 + swz / 64; C = (st & 1) * 32 + (swz % 64) / 2; }
__host__ __device__ __forceinline__ int perm32(int rho) { const int n = rho >> 4, i = rho & 15; return 8 * (i >> 2) + 4 * n + (i & 3); }

struct Unit { int pm, pn; };
struct Gemm { const bf16_t* A; const bf16_t* Bt; int M, N, K; };

struct StaticOrder {
    int nM, nN, nwg, G, c;
    __host__ __device__ void init(int M, int N, int G_, int c_) { nM = M / BM; nN = N / BM; nwg = nM * nN; G = G_; c = c_; }
    __host__ __device__ bool next(int i, Unit& u) const {
        const long L = (long)i * G + c; if (L >= nwg) return false;
        int wgid = (int)L; { const int q = nwg / NXCD, r = nwg % NXCD, xcd = wgid % NXCD, off = wgid / NXCD; wgid = (xcd < r ? xcd * (q + 1) : r * (q + 1) + (xcd - r) * q) + off; }
        const int nig = WGM * nN, gid = wgid / nig, fm = gid * WGM, gsz = (nM - fm) < WGM ? (nM - fm) : WGM;
        u.pm = fm + ((wgid % nig) % gsz); u.pn = (wgid % nig) / gsz; return true;
    }
    __device__ __forceinline__ void a_ready(const Unit&) const {}
    __device__ __forceinline__ void done(const Unit&) const {}
};

__device__ __forceinline__ f32x2 gelu_pk(f32x2 v) {
    const f32x2 av = __builtin_elementwise_abs(v), d = av * 0.2316418882f + 1.0f;
    f32x2 t; t.x = __builtin_amdgcn_rcpf(d.x); t.y = __builtin_amdgcn_rcpf(d.y);
    f32x2 q = t * 0.5307027145f + (-0.7265760135f); q = q * t + 0.7107068705f; q = q * t + (-0.142248368f); q = q * t + 0.127414796f; q = q * t;
    const f32x2 s = (v * v) * (-0.72134752044f);
    f32x2 e; e.x = __builtin_amdgcn_exp2f(s.x); e.y = __builtin_amdgcn_exp2f(s.y);
    const f32x2 m = v * (q * e), r = v - m;
    f32x2 o; o.x = v.x < 0.f ? m.x : r.x; o.y = v.y < 0.f ? m.y : r.y; return o;
}

__device__ __forceinline__ float gelu1(float v) {
    const float av = __builtin_fabsf(v), t = __builtin_amdgcn_rcpf(av * 0.2316418882f + 1.0f);
    float q = t * 0.5307027145f + (-0.7265760135f); q = q * t + 0.7107068705f; q = q * t + (-0.142248368f); q = q * t + 0.127414796f; q = q * t;
    const float e = __builtin_amdgcn_exp2f((v * v) * (-0.72134752044f)), m = v * (q * e);
    return v < 0.f ? m : v - m;
}

struct EpiQKV {
    static constexpr bool PERM = true, AFTER_DRAIN = false;
    bf16_t* O; const float* gqa; const float* gka; const float* gqb; const float* gkb; LAS float* P; float scale;
    __device__ __forceinline__ void operator()(f32x4 (&acc)[2][2][4][2], const Unit& u, int wr, int wc, int fr, int fq) const {
        const int grp = u.pn >> 3;
        const float* gain = grp == 0 ? gqa : grp == 1 ? gka : grp == 3 ? gqb : grp == 4 ? gkb : nullptr;
#pragma unroll
        for (int ai = 0; ai < 2; ++ai)
#pragma unroll
            for (int bj = 0; bj < 2; ++bj)
#pragma unroll
                for (int m = 0; m < 4; ++m)
#pragma unroll
                    for (int n = 0; n < 2; ++n) acc[ai][bj][m][n] = acc[ai][bj][m][n] * scale;
        if (gain) {
#pragma unroll
            for (int ai = 0; ai < 2; ++ai)
#pragma unroll
                for (int m = 0; m < 4; ++m)
#pragma unroll
                    for (int bj = 0; bj < 2; ++bj) {
                        const f32x4 a = acc[ai][bj][m][0], b = acc[ai][bj][m][1];
                        float s = (a[0] * a[0] + a[1] * a[1]) + (a[2] * a[2] + a[3] * a[3]) + (b[0] * b[0] + b[1] * b[1]) + (b[2] * b[2] + b[3] * b[3]);
                        s += __shfl_xor(s, 16); s += __shfl_xor(s, 32);
                        if (fq == 0) P[((ai * HALF + wr * 64 + m * 16 + fr) * 2 + bj) * 4 + wc] = s;
                    }
            asm volatile("s_waitcnt lgkmcnt(0)" ::: "memory"); __builtin_amdgcn_s_barrier(); asm volatile("" ::: "memory");
            f32x4 g0 = *(const f32x4*)(gain + wc * 32 + 8 * fq), g1 = *(const f32x4*)(gain + wc * 32 + 8 * fq + 4);
#pragma unroll
            for (int ai = 0; ai < 2; ++ai)
#pragma unroll
                for (int m = 0; m < 4; ++m)
#pragma unroll
                    for (int bj = 0; bj < 2; ++bj) {
                        const f32x4 pp = *(const LAS f32x4*)(P + ((ai * HALF + wr * 64 + m * 16 + fr) * 2 + bj) * 4);
                        const float rinv = __builtin_amdgcn_rsqf(((pp[0] + pp[1]) + (pp[2] + pp[3])) * (1.0f / 128.0f) + NORM_EPS);
                        acc[ai][bj][m][0] = acc[ai][bj][m][0] * rinv * g0; acc[ai][bj][m][1] = acc[ai][bj][m][1] * rinv * g1;
                    }
        }
#pragma unroll
        for (int ai = 0; ai < 2; ++ai)
#pragma unroll
            for (int m = 0; m < 4; ++m) { const size_t row = (size_t)(u.pm * BM + ai * HALF + wr * 64 + m * 16 + fr);
#pragma unroll
                for (int bj = 0; bj < 2; ++bj) { const f32x4 v0 = acc[ai][bj][m][0], v1 = acc[ai][bj][m][1];
                    u32x4 w; w.x = cvt_pk_bf16(v0[0], v0[1]); w.y = cvt_pk_bf16(v0[2], v0[3]); w.z = cvt_pk_bf16(v1[0], v1[1]); w.w = cvt_pk_bf16(v1[2], v1[3]);
                    *(u32x4*)(O + ((size_t)(u.pn * 2 + bj) * NTOK + row) * HD + wc * 32 + 8 * fq) = w; } }
        if (gain) { asm volatile("s_waitcnt lgkmcnt(0)" ::: "memory"); __builtin_amdgcn_s_barrier(); asm volatile("" ::: "memory"); }
    }
};
__device__ __forceinline__ f32x4 unpack4_bf16(u32x2 w) { return (f32x4){__uint_as_float(w.x << 16), __uint_as_float(w.x & 0xffff0000u), __uint_as_float(w.y << 16), __uint_as_float(w.y & 0xffff0000u)}; }
template <bool BF> struct ErVec { typedef f32x4 type; };
template <> struct ErVec<true> { typedef u32x2 type; };
__device__ __forceinline__ f32x4 er_to4(u32x2 w) { return unpack4_bf16(w); }
__device__ __forceinline__ f32x4 er_to4(f32x4 v) { return v; }
template <bool BASE_BF16, bool OUT_BF16>
struct EpiResid {
    static constexpr bool PERM = OUT_BF16, AFTER_DRAIN = false;
    static constexpr int FQS = PERM ? 8 : 4, NST = PERM ? 4 : 16;
    const void* base; void* out; const float* gate; float scale;
    __device__ __forceinline__ void operator()(f32x4 (&acc)[2][2][4][2], const Unit& u, int wr, int wc, int fr, int fq) const {
        const int row0 = u.pm * BM + wr * 64 + fr, col0 = u.pn * BM + wc * 32 + FQS * fq;
        const float* gp = gate + (size_t)(u.pm >> 4) * NMOD + col0;
        f32x4 gv[2][2];
#pragma unroll
        for (int bj = 0; bj < 2; ++bj)
#pragma unroll
            for (int n = 0; n < 2; ++n) gv[bj][n] = *(const f32x4*)(gp + bj * HALF + n * NST) * scale;
#define ER_OFF(ai, mh, m2, bj, n) ((size_t)(row0 + (ai) * HALF + ((mh) * 2 + (m2)) * 16) * DM + col0 + (bj) * HALF + (n) * NST)
#define ER_LOAD(BS, ai, mh) do { _Pragma("unroll") for (int m2 = 0; m2 < 2; ++m2) _Pragma("unroll") for (int bj = 0; bj < 2; ++bj) _Pragma("unroll") for (int n = 0; n < 2; ++n)       \
            BS[m2][bj][n] = *(const BT*)((const char*)base + ER_OFF(ai, mh, m2, bj, n) * (BASE_BF16 ? 2 : 4)); } while (0)
#define ER_PROC(BS, ai, mh) do { _Pragma("unroll") for (int m2 = 0; m2 < 2; ++m2) _Pragma("unroll") for (int bj = 0; bj < 2; ++bj) {                                                   \
            const f32x4 r0 = er_to4(BS[m2][bj][0]) + gv[bj][0] * acc[ai][bj][(mh) * 2 + m2][0], r1 = er_to4(BS[m2][bj][1]) + gv[bj][1] * acc[ai][bj][(mh) * 2 + m2][1];                \
            if constexpr (OUT_BF16) { u32x4 w; w.x = cvt_pk_bf16(r0[0], r0[1]); w.y = cvt_pk_bf16(r0[2], r0[3]); w.z = cvt_pk_bf16(r1[0], r1[1]); w.w = cvt_pk_bf16(r1[2], r1[3]);       \
                                      *(u32x4*)((bf16_t*)out + ER_OFF(ai, mh, m2, bj, 0)) = w; }                                                                                      \
            else { *(f32x4*)((float*)out + ER_OFF(ai, mh, m2, bj, 0)) = r0; *(f32x4*)((float*)out + ER_OFF(ai, mh, m2, bj, 1)) = r1; } }                                               \
            asm volatile("" ::: "memory"); } while (0)
        using BT = typename ErVec<BASE_BF16>::type;
        BT bA[2][2][2];
        if constexpr (BASE_BF16) {
            BT bB[2][2][2], bC[2][2][2];
            ER_LOAD(bA, 0, 0); ER_LOAD(bB, 0, 1); ER_LOAD(bC, 1, 0); asm volatile("" ::: "memory");
            ER_PROC(bA, 0, 0); ER_LOAD(bA, 1, 1); asm volatile("" ::: "memory");
            ER_PROC(bB, 0, 1); ER_PROC(bC, 1, 0); ER_PROC(bA, 1, 1);
        } else {
            ER_LOAD(bA, 0, 0); ER_PROC(bA, 0, 0); ER_LOAD(bA, 0, 1); ER_PROC(bA, 0, 1);
            ER_LOAD(bA, 1, 0); ER_PROC(bA, 1, 0); ER_LOAD(bA, 1, 1); ER_PROC(bA, 1, 1);
        }
#undef ER_OFF
#undef ER_LOAD
#undef ER_PROC
    }
};
struct EpiF32 {
    static constexpr bool PERM = false, AFTER_DRAIN = false;
    float* C; int ldc;
    __device__ __forceinline__ void operator()(f32x4 (&acc)[2][2][4][2], const Unit& u, int wr, int wc, int fr, int fq) const {
        const int row0 = u.pm * BM + wr * 64 + fr, col0 = u.pn * BM + wc * 32 + 4 * fq;
#pragma unroll
        for (int ai = 0; ai < 2; ++ai)
#pragma unroll
            for (int m = 0; m < 4; ++m) { float* rowp = C + (size_t)(row0 + ai * HALF + m * 16) * ldc + col0;
#pragma unroll
                for (int bj = 0; bj < 2; ++bj)
#pragma unroll
                    for (int n = 0; n < 2; ++n) *(f32x4*)(rowp + bj * HALF + n * 16) = acc[ai][bj][m][n]; }
    }
};
struct EpiScoreT {
    static constexpr bool PERM = false, AFTER_DRAIN = false;
    float* C;
    __device__ __forceinline__ void operator()(f32x4 (&acc)[2][2][4][2], const Unit& u, int wr, int wc, int fr, int fq) const {
#pragma unroll
        for (int ai = 0; ai < 2; ++ai)
#pragma unroll
            for (int bj = 0; bj < 2; ++bj) { float* base = C + ((size_t)((u.pn * 2 + bj) * 256 + (u.pm * 4 + ai * 2 + wr)) * 128 + wc * 32 + 4 * fq) * 64 + fr;
#pragma unroll
                for (int m = 0; m < 4; ++m)
#pragma unroll
                    for (int n = 0; n < 2; ++n)
#pragma unroll
                        for (int i = 0; i < 4; ++i) base[(n * 16 + i) * 64 + m * 16] = acc[ai][bj][m][n][i]; }
    }
};
__host__ __device__ __forceinline__ size_t gd_off(int row, int e) {
    const int pm = row >> 8, r = row & 255, ai = r >> 7, wr = (r >> 6) & 1, m = (r >> 4) & 3, fr = r & 15;
    const int pn = e >> 8, ec = e & 255, bj = ec >> 7, wc = (ec >> 5) & 3, fqh = (ec >> 4) & 1, b16 = ec & 15;
    return ((((((size_t)(pm * 64 + pn) * 2 + ai) * 4 + m) * 2 + bj) * 8 + (wr * 4 + wc)) * 16 + fr) * 32 + fqh * 16 + b16;
}
struct EpiSlot {
    static constexpr bool PERM = true, AFTER_DRAIN = false;
    const unsigned char* G; int ldc; float ascale; float* pre;
    __device__ __forceinline__ void operator()(f32x4 (&acc)[2][2][4][2], const Unit& u, int wr, int wc, int fr, int fq) const {
        const int row0 = u.pm * BM + wr * 64 + fr;
        const unsigned char* base = G + ((size_t)(u.pm * 64 + u.pn) * 65536) + (size_t)(wr * 4 + wc) * 512 + fr * 32 + fq * 8;
        u32x2 gw[2][4][2];
#pragma unroll
        for (int ai = 0; ai < 2; ++ai)
#pragma unroll
            for (int m = 0; m < 4; ++m)
#pragma unroll
                for (int bj = 0; bj < 2; ++bj) gw[ai][m][bj] = *(const u32x2*)(base + ((ai * 4 + m) * 2 + bj) * 4096);
#pragma unroll
        for (int ai = 0; ai < 2; ++ai)
#pragma unroll
            for (int m = 0; m < 4; ++m)
#pragma unroll
                for (int bj = 0; bj < 2; ++bj) {
                    const u32x2 g = gw[ai][m][bj];
                    if ((g.x | g.y) != 0u) {
                        float* prow = pre + (size_t)(row0 + ai * HALF + m * 16) * 128 - 1;
#pragma unroll
                        for (int e = 0; e < 8; ++e) { const unsigned sl = ((e < 4 ? g.x : g.y) >> (8 * (e & 3))) & 0xffu;
                            if (sl) prow[sl] = acc[ai][bj][m][e >> 2][e & 3] * ascale; }
                    }
                }
    }
};

template <class Epi, class Sched, bool ALIGN_EPI = false, bool SP2 = false, int ES = 2, bool ATILE = false>
__device__ __forceinline__ void gemm_phase(LAS unsigned char* lds, const Gemm g, const Sched& S, const Epi& E, int wv_) {
    int tid_o = TIDX;
    const int tid = tid_o, wid = wv_, lane = tid & 63, wr = wid >> 2, wc = wid & 3, fr = lane & 15, fq = lane >> 4;
    const int K = g.K * (ES == 2 ? 2 : 1) / 2  , nt = K / BK;
    unsigned voffA[2], voffB[2];
#pragma unroll
    for (int i = 0; i < 2; ++i) { int R, C; stage_rc(tid * 16 + i * 8192, R, C); const int Rb = Epi::PERM ? ((R & ~31) + perm32(R & 31)) : R;
        voffA[i] = ATILE ? (unsigned)(((R >> 4) & 3) * 8192 + (R >> 6) * 2048 + (R & 15) * 32 + ((C >> 3) >> 1) * 512 + ((C >> 3) & 1) * 16) : (unsigned)(R * K + C) * 2u;
        voffB[i] = (unsigned)(Rb * K + C) * 2u; }
    const size_t kstep = (size_t)(BK * 2);
    const size_t hstep = (size_t)HALF * K * 2;
    const size_t tstep = 2 * hstep;
    const size_t hstepA = ATILE ? (size_t)32768 : hstep;
#define PG8_KA(t_) (ATILE ? ((size_t)((t_) >> 1) * 65536 + (size_t)((t_) & 1) * 4096) : (size_t)(t_) * kstep)
    const unsigned ldsw = (unsigned)wid * 1024u;
    const int aoff = lds_byte(wr * 64 + fr, fq * 8), boff = lds_byte(wc * 32 + fr, fq * 8);
#define PG8_SA(b, h) (((b) * 2 + (h)) * HTB)
#define PG8_SB(b, h) ((4 + (b) * 2 + (h)) * HTB)
#define PG8_STAGE(bufoff, gbase, voff) do { _Pragma("unroll") for (int _i = 0; _i < 2; ++_i) \
        __builtin_amdgcn_global_load_lds((const unsigned*)((const char*)(gbase) + (voff)[_i]), (LAS unsigned*)(lds + (bufoff) + ldsw + _i * 8192), 16, 0, 0); } while (0)
#define PG8_RD(off) (*(const LAS bf16x8*)(lds + (off)))
#define PG8_CAT2(x, y) __builtin_shufflevector(__builtin_bit_cast(i32x4, (x)), __builtin_bit_cast(i32x4, (y)), 0, 1, 2, 3, 4, 5, 6, 7)
#define PG8_RD6(off) __builtin_shufflevector(__builtin_shufflevector(*(const LAS i32x4*)(lds + (off)), *(const LAS i32x4*)(lds + (off)), 0, 1, 2, 3, -1, -1), \
                                             __builtin_shufflevector(*(const LAS i32x2*)(lds + (off) + 1024), *(const LAS i32x2*)(lds + (off) + 1024), 0, 1, -1, -1, -1, -1), 0, 1, 2, 3, 6, 7)
#define PG8_LDA(dst, b, h) do { _Pragma("unroll") for (int m = 0; m < 4; ++m) { const int o_ = PG8_SA(b, h) + aoff + m * 2048; \
        if constexpr (ES == 2) { dst[m][0] = PG8_RD(o_); dst[m][1] = PG8_RD(o_ + 1024); } else if constexpr (ES == 1) dst##8[m] = PG8_CAT2(PG8_RD(o_), PG8_RD(o_ + 1024)); else dst##6[m] = PG8_RD6(o_); } } while (0)
#define PG8_LDB(dst, b, h) do { _Pragma("unroll") for (int n = 0; n < 2; ++n) { const int o_ = PG8_SB(b, h) + boff + n * 2048; \
        if constexpr (ES == 2) { dst[n][0] = PG8_RD(o_); dst[n][1] = PG8_RD(o_ + 1024); } else if constexpr (ES == 1) dst##8[n] = PG8_CAT2(PG8_RD(o_), PG8_RD(o_ + 1024)); else dst##6[n] = PG8_RD6(o_); } } while (0)
#define PG8_MMA(ai, bj, At, Bt) do { __builtin_amdgcn_s_setprio(1); _Pragma("unroll") for (int m = 0; m < 4; ++m) _Pragma("unroll") for (int n = 0; n < 2; ++n) { \
        if constexpr (ES == 2) { _Pragma("unroll") for (int k = 0; k < 2; ++k) acc[ai][bj][m][n] = __builtin_amdgcn_mfma_f32_16x16x32_bf16(Bt[n][k], At[m][k], acc[ai][bj][m][n], 0, 0, 0); } \
        else if constexpr (ES == 1) asm volatile("v_mfma_f32_16x16x128_f8f6f4 %0, %1, %2, %0" : "+v"(acc[ai][bj][m][n]) : "v"(Bt##8[n]), "v"(At##8[m])); \
        else asm volatile("v_mfma_f32_16x16x128_f8f6f4 %0, %1, %2, %0 cbsz:2 blgp:2" : "+v"(acc[ai][bj][m][n]) : "v"(Bt##6[n]), "v"(At##6[m])); } \
        __builtin_amdgcn_s_setprio(0); } while (0)
#define PG8_WAIT_V(n) asm volatile("s_waitcnt vmcnt(" #n ")" ::: "memory")
#define PG8_WAIT_L(n) asm volatile("s_waitcnt lgkmcnt(" #n ")" ::: "memory")
#define PG8_BAR __builtin_amdgcn_s_barrier()
#define PG8_SCHED __builtin_amdgcn_sched_barrier(0)
    Unit cur, nxt; int ui = 0;
    if (!S.next(0, cur)) return;
    f32x4 acc[2][2][4][2];
#pragma unroll
    for (int a = 0; a < 2; ++a)
#pragma unroll
        for (int b = 0; b < 2; ++b)
#pragma unroll
            for (int m = 0; m < 4; ++m)
#pragma unroll
                for (int n = 0; n < 2; ++n) acc[a][b][m][n] = (f32x4){0.f, 0.f, 0.f, 0.f};
    bf16x8 At[4][2], B0[2][2], B1[2][2]; i32x8 At8[4], B08[2], B18[2]; i32x6 At6[4], B06[2], B16[2];
    const char* cA = (const char*)g.A + (size_t)cur.pm * tstep; const char* cB = (const char*)g.Bt + (size_t)cur.pn * tstep;
    S.a_ready(cur);
    if constexpr (SP2) {
        PG8_STAGE(PG8_SB(0, 0), cB, voffB); PG8_STAGE(PG8_SB(0, 1), cB + hstep, voffB); PG8_STAGE(PG8_SA(0, 0), cA, voffA); PG8_STAGE(PG8_SA(0, 1), cA + hstepA, voffA);
        if (wr == 1) PG8_BAR;
        PG8_WAIT_V(2); PG8_BAR;
        PG8_STAGE(PG8_SB(1, 0), cB + kstep, voffB); PG8_STAGE(PG8_SA(1, 0), cA + PG8_KA(1), voffA); PG8_STAGE(PG8_SB(1, 1), cB + hstep + kstep, voffB);
        PG8_WAIT_V(6); PG8_BAR;
    } else {
        PG8_STAGE(PG8_SB(0, 0), cB, voffB); PG8_STAGE(PG8_SA(0, 0), cA, voffA); PG8_STAGE(PG8_SB(0, 1), cB + hstep, voffB); PG8_STAGE(PG8_SA(0, 1), cA + hstepA, voffA);
        if (wr == 1) PG8_BAR;
        PG8_WAIT_V(4); PG8_BAR;
        PG8_STAGE(PG8_SB(1, 0), cB + kstep, voffB); PG8_STAGE(PG8_SA(1, 0), cA + PG8_KA(1), voffA); PG8_STAGE(PG8_SB(1, 1), cB + hstep + kstep, voffB);
        PG8_WAIT_V(6); PG8_BAR;
    }
    for (;;) {
        const bool has_next = S.next(ui + 1, nxt);
        const char* nA = has_next ? (const char*)g.A + (size_t)nxt.pm * tstep : cA; const char* nB = has_next ? (const char*)g.Bt + (size_t)nxt.pn * tstep : cB;
        for (int t = 0; t < nt; t += 2) {
            const bool last = (t == nt - 2);
            const char* a1 = cA + PG8_KA(t + 1);
            const char* a2 = last ? nA : cA + PG8_KA(t + 2); const char* b2 = last ? nB : cB + (size_t)(t + 2) * kstep;
            const char* a3 = a2 + PG8_KA(1); const char* b3 = b2 + kstep;
            if (last && has_next) S.a_ready(nxt);
            if constexpr (SP2) {
            PG8_LDB(B0, 0, 0); PG8_LDB(B1, 0, 1); PG8_SCHED; PG8_LDA(At, 0, 0); PG8_STAGE(PG8_SA(1, 1), a1 + hstepA, voffA);
            PG8_WAIT_V(8); PG8_WAIT_L(0); PG8_BAR; PG8_MMA(0, 0, At, B0); PG8_MMA(0, 1, At, B1); PG8_BAR; PG8_SCHED;
            PG8_LDA(At, 0, 1); PG8_STAGE(PG8_SB(0, 0), b2, voffB); PG8_STAGE(PG8_SB(0, 1), b2 + hstep, voffB); PG8_STAGE(PG8_SA(0, 0), a2, voffA);
            PG8_WAIT_V(8); PG8_WAIT_L(0); PG8_BAR; PG8_MMA(1, 0, At, B0); PG8_MMA(1, 1, At, B1); PG8_BAR; PG8_SCHED;
            PG8_LDB(B0, 1, 0); PG8_LDB(B1, 1, 1); PG8_SCHED; PG8_LDA(At, 1, 0); PG8_STAGE(PG8_SA(0, 1), a2 + hstepA, voffA);
            PG8_WAIT_V(8); PG8_WAIT_L(0); PG8_BAR; PG8_MMA(0, 0, At, B0); PG8_MMA(0, 1, At, B1); PG8_BAR; PG8_SCHED;
            PG8_LDA(At, 1, 1); PG8_STAGE(PG8_SB(1, 0), b3, voffB); PG8_STAGE(PG8_SB(1, 1), b3 + hstep, voffB); PG8_STAGE(PG8_SA(1, 0), a3, voffA);
            PG8_WAIT_V(8); PG8_WAIT_L(0); PG8_BAR; PG8_MMA(1, 0, At, B0); PG8_MMA(1, 1, At, B1); PG8_BAR; PG8_SCHED;
            } else {
            PG8_LDB(B0, 0, 0); PG8_SCHED; PG8_LDA(At, 0, 0); PG8_STAGE(PG8_SA(1, 1), a1 + hstepA, voffA);
            PG8_WAIT_L(8); PG8_BAR; PG8_WAIT_L(0); PG8_MMA(0, 0, At, B0); PG8_BAR; PG8_SCHED;
            PG8_LDB(B1, 0, 1); PG8_STAGE(PG8_SB(0, 0), b2, voffB);
            PG8_BAR; PG8_WAIT_L(0); PG8_MMA(0, 1, At, B1); PG8_BAR;
            PG8_LDA(At, 0, 1); PG8_STAGE(PG8_SA(0, 0), a2, voffA);
            PG8_BAR; PG8_WAIT_L(0); PG8_MMA(1, 0, At, B0); PG8_BAR; PG8_SCHED;
            PG8_STAGE(PG8_SB(0, 1), b2 + hstep, voffB);
            PG8_WAIT_V(6); PG8_BAR; PG8_MMA(1, 1, At, B1); PG8_BAR;
            PG8_LDB(B0, 1, 0); PG8_SCHED; PG8_LDA(At, 1, 0); PG8_STAGE(PG8_SA(0, 1), a2 + hstepA, voffA);
            PG8_WAIT_L(8); PG8_BAR; PG8_WAIT_L(0); PG8_MMA(0, 0, At, B0); PG8_BAR; PG8_SCHED;
            PG8_LDB(B1, 1, 1); PG8_STAGE(PG8_SB(1, 0), b3, voffB);
            PG8_BAR; PG8_WAIT_L(0); PG8_MMA(0, 1, At, B1); PG8_BAR;
            PG8_LDA(At, 1, 1); PG8_STAGE(PG8_SA(1, 0), a3, voffA);
            PG8_BAR; PG8_WAIT_L(0); PG8_MMA(1, 0, At, B0); PG8_BAR; PG8_SCHED;
            PG8_STAGE(PG8_SB(1, 1), b3 + hstep, voffB);
            PG8_WAIT_V(6); PG8_BAR; PG8_MMA(1, 1, At, B1); PG8_BAR;
            }
        }
        if constexpr (ES != 2) asm volatile("s_nop 15\n\ts_nop 15" ::: "memory");
        if constexpr (ALIGN_EPI) { if (wr == 0) PG8_BAR; }
        if constexpr (!Epi::AFTER_DRAIN) { E(acc, cur, wr, wc, fr, fq); S.done(cur); }
        if (!has_next) break;
#pragma unroll
        for (int a = 0; a < 2; ++a)
#pragma unroll
            for (int b = 0; b < 2; ++b)
#pragma unroll
                for (int m = 0; m < 4; ++m)
#pragma unroll
                    for (int n = 0; n < 2; ++n) acc[a][b][m][n] = (f32x4){0.f, 0.f, 0.f, 0.f};
        cur = nxt; cA = nA; cB = nB; ++ui;
        if constexpr (ALIGN_EPI) { if (wr == 1) PG8_BAR; }
    }
    PG8_WAIT_V(0);
    if constexpr (!ALIGN_EPI) { if (wr == 0) PG8_BAR; }
    PG8_BAR;
#undef PG8_SA
#undef PG8_KA
#undef PG8_SB
#undef PG8_STAGE
#undef PG8_LDA
#undef PG8_LDB
#undef PG8_MMA
#undef PG8_CAT2
#undef PG8_RD
#undef PG8_RD6
#undef PG8_WAIT_V
#undef PG8_WAIT_L
#undef PG8_BAR
#undef PG8_SCHED
}
}

__device__ __forceinline__ float wave_sum(float v) {
#pragma unroll
    for (int o = 32; o >= 1; o >>= 1) v += __shfl_xor(v, o);
    return v;
}
__device__ __forceinline__ u32x2 pack4(f32x4 v) { u32x2 w; w.x = cvt_pk_bf16(v[0], v[1]); w.y = cvt_pk_bf16(v[2], v[3]); return w; }
__device__ __forceinline__ u32x4 pack8(f32x4 a, f32x4 b) { u32x4 w; w.x = cvt_pk_bf16(a[0], a[1]); w.y = cvt_pk_bf16(a[2], a[3]); w.z = cvt_pk_bf16(b[0], b[1]); w.w = cvt_pk_bf16(b[2], b[3]); return w; }

__device__ __forceinline__ void p0_mod(const float* c, const float* w_ada, const float* b_ada, float* mod, LAS unsigned char* lds, int bid, int nb, int wv_) {
    const int tid = TIDX;
    LAS float* s = (LAS float*)lds;
    LAS float* red = (LAS float*)(lds + 65536);
    for (int i = tid; i < NBATCH * DM; i += NTHREADS) { const float v = c[i]; s[i] = v / (1.0f + __expf(-v)); }
    __syncthreads();
    const int cq = tid % 24, kl = tid / 24;
    for (int chunk = bid; chunk < NMOD / 96; chunk += nb) {
        float acc[4][4];
#pragma unroll
        for (int b = 0; b < 4; ++b)
#pragma unroll
            for (int j = 0; j < 4; ++j) acc[b][j] = 0.f;
        if (tid < 504) {
            const float* wp = w_ada + (size_t)chunk * 96 + cq * 4;
#pragma unroll 8
            for (int k = kl; k < DM; k += 21) {
                const f32x4 w = *(const f32x4*)(wp + (size_t)k * NMOD);
#pragma unroll
                for (int b = 0; b < 4; ++b) { const float sb = s[b * DM + k];
#pragma unroll
                    for (int j = 0; j < 4; ++j) acc[b][j] += sb * w[j]; }
            }
#pragma unroll
            for (int b = 0; b < 4; ++b)
#pragma unroll
                for (int j = 0; j < 4; ++j) red[(kl * 4 + b) * 96 + cq * 4 + j] = acc[b][j];
        }
        __syncthreads();
        if (tid < 384) { const int b = tid / 96, cc = tid % 96; float t = 0.f;
            for (int k = 0; k < 21; ++k) t += red[(k * 4 + b) * 96 + cc];
            mod[(size_t)b * NMOD + chunk * 96 + cc] = t + b_ada[chunk * 96 + cc]; }
        __syncthreads();
    }
}
__device__ __forceinline__ void p0_transpose(const float* src, size_t ldS, unsigned char* dst, size_t ldD, int R, int C, float scale, LAS unsigned char* lds, int bid, int nb, int wv_) {
    const int tid = TIDX; LAS float* tile = (LAS float*)lds;
    const int ntc = C / 64, ntiles = (R / 256) * ntc;
    f32x4 v[8];
#define P0T_LOAD(t_) do { const int tr_ = (t_) / ntc, tc_ = (t_) % ntc; _Pragma("unroll") for (int i = 0; i < 8; ++i) { const int r = (tid >> 4) + 32 * i, c4 = (tid & 15) * 4; \
        v[i] = *(const f32x4*)(src + (size_t)(tr_ * 256 + r) * ldS + tc_ * 64 + c4); } } while (0)
    if (bid < ntiles) P0T_LOAD(bid);
    for (int t = bid; t < ntiles; t += nb) {
        const int tr = t / ntc, tc = t % ntc;
#pragma unroll
        for (int i = 0; i < 8; ++i) { const int r = (tid >> 4) + 32 * i, c4 = (tid & 15) * 4;
#pragma unroll
            for (int j = 0; j < 4; ++j) tile[r * 65 + c4 + j] = v[i][j]; }
        __syncthreads();
        if (t + nb < ntiles) P0T_LOAD(t + nb);
        { const int cc = tid >> 3, r0 = (tid & 7) * 32; u32x2 w[4];
#pragma unroll
            for (int q = 0; q < 4; ++q) { f32x4 a, b;
#pragma unroll
                for (int j = 0; j < 4; ++j) { a[j] = tile[(r0 + q * 8 + j) * 65 + cc] * scale; b[j] = tile[(r0 + q * 8 + 4 + j) * 65 + cc] * scale; }
                w[q] = pack8_fp8(a, b); }
            unsigned char* dp = dst + (size_t)(tc * 64 + cc) * ldD + tr * 256 + r0;
            *(u32x4*)dp = (u32x4){w[0].x, w[0].y, w[1].x, w[1].y}; *(u32x4*)(dp + 16) = (u32x4){w[2].x, w[2].y, w[3].x, w[3].y}; }
        __syncthreads();
    }
#undef P0T_LOAD
}
__device__ __forceinline__ void p0_wc(const float* w_pq, const float* sk1, const float* sk2, bf16_t* wct, LAS unsigned char* lds, int bid, int nb, int wv_) {
    const int tid = TIDX, kk = tid & 63, kg = tid >> 6;
    LAS float* Ws = (LAS float*)lds;
    LAS float* Ss = (LAS float*)(lds + 64 * 132 * 4);
    for (int task = bid; task < 16 * 64; task += nb) {
        const int hh = task >> 6, kc = task & 63; const float* sk = (hh & 1) ? sk2 : sk1;
#pragma unroll
        for (int i = 0; i < 4; ++i) { const int idx = tid + 512 * i, r = idx >> 5, c4 = (idx & 31) * 4;
            *(LAS f32x4*)(Ws + r * 132 + c4) = *(const f32x4*)(w_pq + (size_t)(kc * 64 + r) * (PHEADS * 256) + hh * 128 + c4); }
#pragma unroll
        for (int i = 0; i < 8; ++i) { const int idx = tid + 512 * i, r = idx >> 5, c4 = (idx & 31) * 4;
            *(LAS f32x4*)(Ss + r * 132 + c4) = *(const f32x4*)(sk + (size_t)r * 128 + c4); }
        __syncthreads();
        float acc[4][4];
#pragma unroll
        for (int i = 0; i < 4; ++i)
#pragma unroll
            for (int j = 0; j < 4; ++j) acc[i][j] = 0.f;
        const int tk = tid & 15, tj = tid >> 4;
#pragma unroll 4
        for (int d4 = 0; d4 < 32; ++d4) {
            f32x4 w[4], sv[4];
#pragma unroll
            for (int i = 0; i < 4; ++i) w[i] = *(const LAS f32x4*)(Ws + (tk + 16 * i) * 132 + d4 * 4);
#pragma unroll
            for (int j = 0; j < 4; ++j) sv[j] = *(const LAS f32x4*)(Ss + (4 * tj + j) * 132 + d4 * 4);
#pragma unroll
            for (int i = 0; i < 4; ++i)
#pragma unroll
                for (int j = 0; j < 4; ++j) acc[i][j] += (w[i][0] * sv[j][0] + w[i][1] * sv[j][1]) + (w[i][2] * sv[j][2] + w[i][3] * sv[j][3]);
        }
#pragma unroll
        for (int i = 0; i < 4; ++i)
#pragma unroll
            for (int j = 0; j < 4; ++j) wct[(size_t)(hh * 128 + 4 * tj + j) * DM + kc * 64 + tk + 16 * i] = f2bf(acc[i][j]);
        __syncthreads();
    }
}
__device__ __forceinline__ void p0_prologue(const Args& a, LAS unsigned char* lds, int bid, int nb, int wv_) {
    unsigned char* ws = a.ws; const int tid = TIDX;
    p0_mod(a.in[1], a.in[2], a.in[3], (float*)(ws + WS_MOD), lds, bid, nb, wv_);
    p0_transpose(a.in[5], INC, ws + WS_WINT, DM, DM, NQKV, 64.0f, lds, bid, nb, wv_);
    p0_transpose(a.in[12], DM, ws + WS_WOT, DM, DM, DM, 64.0f, lds, bid, nb, wv_);
    p0_transpose(a.in[18], DM, ws + WS_VT, NEXP, NEXP, DM, 1.0f, lds, bid, nb, wv_);
    p0_wc(a.in[14], a.in[15], a.in[16], (bf16_t*)(ws + WS_WCT), lds, bid, nb, wv_);
    {
        const float* u = a.in[17]; unsigned char* ub = ws + WS_UB; const size_t n8 = (size_t)NEXP * DM / 8;
        const size_t st = (size_t)nb * NTHREADS; size_t i = (size_t)bid * NTHREADS + tid;
        for (; i + 7 * st < n8; i += 8 * st) {
            f32x4 x[16];
#pragma unroll
            for (int q = 0; q < 8; ++q) { x[2 * q] = *(const f32x4*)(u + (i + q * st) * 8); x[2 * q + 1] = *(const f32x4*)(u + (i + q * st) * 8 + 4); }
#pragma unroll
            for (int q = 0; q < 8; ++q) *(u32x2*)(ub + (i + q * st) * 8) = pack8_fp8(x[2 * q] * 64.0f, x[2 * q + 1] * 64.0f); }
        for (; i < n8; i += st) {
            const f32x4 x0 = *(const f32x4*)(u + i * 8), x1 = *(const f32x4*)(u + i * 8 + 4); *(u32x2*)(ub + i * 8) = pack8_fp8(x0 * 64.0f, x1 * 64.0f); }
    }
    {
        const float* w = a.in[5]; bf16_t* wf = (bf16_t*)(ws + WS_WFZT);
        for (int k = bid * NTHREADS + tid; k < DM; k += nb * NTHREADS) {
#pragma unroll
            for (int q = 0; q < 4; ++q) { const f32x4 v = *(const f32x4*)(w + (size_t)k * INC + NQKV + q * 4);
#pragma unroll
                for (int j = 0; j < 4; ++j) wf[(size_t)(q * 4 + j) * DM + k] = f2bf(v[j]); } }
    }
}

template <bool WITH_FZ, bool WITH_F8, bool WITH_BF16, bool WITH_F6 = false, bool IN_BF16 = false>
__device__ __forceinline__ void norm_phase(const void* xin, const float* g, const float* sh, const float* sc, bf16_t* out, unsigned char* out8,
                                           const bf16_t* wfzt, const float* b_f, float* logf, LAS unsigned char* lds, int bid, int nb, int wv_) {
    const int tid = TIDX, wid = wv_, lane = tid & 63;
    constexpr int ROWB = DM * 2 + 16;
    LAS float* red = (LAS float*)(lds + 16 * ROWB);
    using XT = typename pg8::ErVec<IN_BF16>::type;
#define NR_LOAD(BUF, row_) do { _Pragma("unroll") for (int j = 0; j < 16; ++j)                                                                                       \
        BUF[j] = *(const XT*)((const char*)xin + ((size_t)(row_) * DM + j * 256 + lane * 4) * (IN_BF16 ? 2 : 4)); } while (0)
#define NR_ROW(BUF, rr_) do { const int lr = wid * 2 + (rr_);                                                                                                        \
            float ss = 0.f;                                                                                                                                            \
            _Pragma("unroll") for (int j = 0; j < 16; ++j) { const f32x4 v = pg8::er_to4(BUF[j]); ss += (v[0] * v[0] + v[1] * v[1]) + (v[2] * v[2] + v[3] * v[3]); }      \
            ss = wave_sum(ss);                                                                                                                                         \
            const float rinv = __builtin_amdgcn_rsqf(ss * (1.0f / DM) + NORM_EPS);                                                                                     \
            _Pragma("unroll") for (int j = 0; j < 16; ++j) { const int cidx = j * 256 + lane * 4;                                                                      \
                const f32x4 vj = pg8::er_to4(BUF[j]);                                                                                                                 \
                f32x4 pa_, ph_;                                                                                                                                        \
                if constexpr (PBF) { pa_ = pg8::unpack4_bf16(*(const LAS u32x2*)(pb + cidx * 2)); ph_ = pg8::unpack4_bf16(*(const LAS u32x2*)(pb + 8192 + cidx * 2)); }   \
                else { pa_ = *(const LAS f32x4*)(pb + cidx * 4); ph_ = *(const LAS f32x4*)(pb + 16384 + cidx * 4); }                                                    \
                const f32x4 y = (vj * rinv) * pa_ + ph_; const u32x2 w = pack4(y);                                                                                     \
                if constexpr (WITH_BF16) *(u32x2*)(out + (size_t)(r0 + lr) * DM + cidx) = w;                                                                            \
                if constexpr (WITH_F8) { int w8 = __builtin_amdgcn_cvt_pk_fp8_f32(y[0], y[1], 0, false); w8 = __builtin_amdgcn_cvt_pk_fp8_f32(y[2], y[3], w8, true); *(int*)(out8 + (size_t)(r0 + lr) * DM + cidx) = w8; } \
                if constexpr (WITH_FZ) *(LAS u32x2*)(lds + lr * ROWB + cidx * 2) = w;                                                                                   \
                if constexpr (WITH_F6) *(LAS u32x2*)(lds + lr * ROWB + cidx * 2) = pack4(y * 1.6f); } } while (0)
    constexpr bool PBF = WITH_FZ || WITH_F6;
    LAS unsigned char* pb = lds + (PBF ? 16 * ROWB + 8192 : 0);
    XT rowA[16], rowB[16];
    if (bid < NTOK / 16) NR_LOAD(rowA, bid * 16 + wid * 2);
    for (int it = bid; it < NTOK / 16; it += nb) {
        const int r0 = it * 16, b = r0 / SEQ;
        {
            const int c8 = tid * 8;
            const f32x4 g0 = *(const f32x4*)(g + c8), g1 = *(const f32x4*)(g + c8 + 4), s0 = *(const f32x4*)(sc + (size_t)b * NMOD + c8), s1 = *(const f32x4*)(sc + (size_t)b * NMOD + c8 + 4);
            const f32x4 h0 = *(const f32x4*)(sh + (size_t)b * NMOD + c8), h1 = *(const f32x4*)(sh + (size_t)b * NMOD + c8 + 4);
            NR_LOAD(rowB, r0 + wid * 2 + 1);
            __syncthreads();
            { const f32x4 a0 = g0 * (s0 + 1.0f), a1 = g1 * (s1 + 1.0f);
              if constexpr (PBF) { *(LAS u32x4*)(pb + c8 * 2) = pack8(a0, a1); *(LAS u32x4*)(pb + 8192 + c8 * 2) = pack8(h0, h1); }
              else { *(LAS f32x4*)(pb + c8 * 4) = a0; *(LAS f32x4*)(pb + c8 * 4 + 16) = a1; *(LAS f32x4*)(pb + 16384 + c8 * 4) = h0; *(LAS f32x4*)(pb + 16384 + c8 * 4 + 16) = h1; } }
            __syncthreads();
            NR_ROW(rowA, 0);
            if (it + nb < NTOK / 16) NR_LOAD(rowA, (it + nb) * 16 + wid * 2);
            NR_ROW(rowB, 1);
        }
        if constexpr (WITH_F6) {
            __syncthreads();
#pragma unroll
            for (int i = 0; i < 4; ++i) { const int G = tid + NTHREADS * i, row = G >> 7, grp = G & 127;
                u32x16 w;
#pragma unroll
                for (int q = 0; q < 4; ++q) { const u32x4 t = *(const LAS u32x4*)(lds + row * ROWB + grp * 64 + q * 16); w[4 * q] = t[0]; w[4 * q + 1] = t[1]; w[4 * q + 2] = t[2]; w[4 * q + 3] = t[3]; }
                const i32x6 pk = __builtin_amdgcn_cvt_scalef32_pk32_fp6_bf16(__builtin_bit_cast(bf16x32, w), 1.0f);
                store_fp6_slot(out8 + (size_t)(r0 + row) * DM + (grp >> 2) * 128, grp & 3, pk); }
            __syncthreads();
        }
        if constexpr (WITH_FZ) {
            f32x4 acc = {0.f, 0.f, 0.f, 0.f}; const int fr = lane & 15, fq = lane >> 4;
            bf16x8 bfr[16];
#pragma unroll
            for (int ks = 0; ks < 16; ++ks) bfr[ks] = *(const bf16x8*)(wfzt + (size_t)fr * DM + wid * 512 + ks * 32 + fq * 8);
            __syncthreads();
#pragma unroll
            for (int ks = 0; ks < 16; ++ks) { const int k0 = wid * 512 + ks * 32 + fq * 8;
                const bf16x8 af = *(const LAS bf16x8*)(lds + fr * ROWB + k0 * 2);
                acc = __builtin_amdgcn_mfma_f32_16x16x32_bf16(af, bfr[ks], acc, 0, 0, 0); }
#pragma unroll
            for (int j = 0; j < 4; ++j) red[wid * 256 + (fq * 4 + j) * 16 + fr] = acc[j];
            __syncthreads();
            if (tid < 256) { float z = 0.f;
                const int row = tid & 15, n = tid >> 4;
#pragma unroll
                for (int w = 0; w < 8; ++w) z += red[w * 256 + row * 16 + n];
                z += b_f[n];
                const float lf = fminf(z, 0.f) - log1pf(__expf(-fabsf(z)));
                const int tok = r0 + row; logf[((size_t)(tok / SEQ) * NHB + n) * SEQ + (tok % SEQ)] = lf; }
            __syncthreads();
        }
    }
}

#undef NR_LOAD
#undef NR_ROW
__device__ __forceinline__ void cumsum_phase(const float* logf, float* nbias, LAS unsigned char* aux, int bid, int nb, int wv_) {
    const int tid = TIDX, wid = wv_, lane = tid & 63; LAS float* wt = (LAS float*)aux;
    for (int seq = bid; seq < NBATCH * NHB; seq += nb) {
        const float* p = logf + (size_t)seq * SEQ + tid * 8; const f32x4 a = *(const f32x4*)p, b = *(const f32x4*)(p + 4);
        float v[8] = {a[0], a[1], a[2], a[3], b[0], b[1], b[2], b[3]};
#pragma unroll
        for (int j = 1; j < 8; ++j) v[j] += v[j - 1];
        float incl = v[7];
#pragma unroll
        for (int o = 1; o < 64; o <<= 1) { const float t = __shfl_up(incl, o); if (lane >= o) incl += t; }
        if (lane == 63) wt[wid] = incl;
        __syncthreads();
        float off = incl - v[7];
        for (int w = 0; w < wid; ++w) off += wt[w];
        f32x4 o0, o1;
#pragma unroll
        for (int j = 0; j < 4; ++j) { o0[j] = -(v[j] + off) * 11.313708498984761f; o1[j] = -(v[4 + j] + off) * 11.313708498984761f; }
        float* q = nbias + (size_t)seq * SEQ + tid * 8; *(f32x4*)q = o0; *(f32x4*)(q + 4) = o1;
        __syncthreads();
    }
}

namespace att {
constexpr float SCALE = 0.08838834764831845f, C2 = 1.4426950408889634f * SCALE, RSCALE = 11.313708498984761f;
constexpr int TAB_N = 2049;
__device__ __forceinline__ int v_rd_base(int lane) { return ((lane & 3) << 3) | (((lane >> 2) & 3) << 6) | (((lane >> 4) & 1) << 5) | (((lane >> 5) & 1) << 8); }
__device__ __forceinline__ int crow(int r, int hi) { return (r & 3) + 8 * (r >> 2) + 4 * hi; }
__device__ __forceinline__ int t5_bucket(int dist) {
    if (dist < 16) return dist;
    const float v = logf((float)dist * (1.0f / 16.0f)) / 4.852030263919617f * 16.0f;
    int large = 16 + (int)v; return large < 31 ? large : 31;
}

}

#ifndef ATT_PROBE
#define ATT_PROBE 0
#endif
#ifndef FOXDBG
#define FOXDBG 1
#endif
namespace att2 {
using att::crow; using att::t5_bucket; using att::v_rd_base;
constexpr float SCALE = att::SCALE, C2 = att::C2, RSCALE = att::RSCALE; constexpr int TAB_N = att::TAB_N;
#define GLDS16(gptr, ldsptr) __builtin_amdgcn_global_load_lds((const unsigned*)(gptr), (LAS unsigned*)(ldsptr), 16, 0, 0)
#define TABIDX(d) ((int)((d) >> 4) + (int)((d) & 15) * 129)
#define VMW(n) asm volatile("s_waitcnt vmcnt(" #n ")" ::: "memory")
#define BAR_LDS() do { asm volatile("s_waitcnt lgkmcnt(0)" ::: "memory"); __builtin_amdgcn_s_barrier(); asm volatile("" ::: "memory"); } while (0)

template <int NP>
__device__ __forceinline__ void softmax_step(f32x16 (&p)[NP], float& m, float& l, f32x16 (&o)[4], bf16x8 (&pa)[2 * NP], LAS float* xch, int r32, int hi) {
    float pmax = p[0][0];
#pragma unroll
    for (int i = 0; i < NP; ++i)
#pragma unroll
        for (int r = 0; r < 16; ++r) pmax = fmaxf(pmax, p[i][r]);
    { auto rr = __builtin_amdgcn_permlane32_swap(__float_as_uint(pmax), __float_as_uint(pmax), false, false);
      pmax = fmaxf(__uint_as_float(rr[0]), __uint_as_float(rr[1])); }
    const float mn = fmaxf(m, pmax);
    const float alpha = __builtin_amdgcn_exp2f((m - mn) * C2);
    m = mn;
    const float mnL = -mn * C2;
    float ps = 0.f;
#pragma unroll
    for (int i = 0; i < NP; ++i)
#pragma unroll
        for (int r = 0; r < 16; ++r) { p[i][r] = __builtin_amdgcn_exp2f(fmaf(p[i][r], C2, mnL)); ps += p[i][r]; }
    { auto rr = __builtin_amdgcn_permlane32_swap(__float_as_uint(ps), __float_as_uint(ps), false, false);
      ps = __uint_as_float(rr[0]) + __uint_as_float(rr[1]); }
    l = l * alpha + ps;
    if (__any(alpha < 1.f)) {
        if (hi == 0) xch[r32] = alpha;
        asm volatile("s_waitcnt lgkmcnt(0)" ::: "memory");
#pragma unroll
        for (int g = 0; g < 4; ++g) { const f32x4 av = *(const LAS f32x4*)(xch + 8 * g + 4 * hi);
#pragma unroll
            for (int d0 = 0; d0 < 4; ++d0) { o[d0][4 * g + 0] *= av[0]; o[d0][4 * g + 1] *= av[1]; o[d0][4 * g + 2] *= av[2]; o[d0][4 * g + 3] *= av[3]; } }
        asm volatile("" ::: "memory");
    }
#define PK4(P, B_, OUT) do { unsigned a0 = cvt_pk_bf16(P[B_+0], P[B_+1]), a1 = cvt_pk_bf16(P[B_+2], P[B_+3]);                \
        unsigned b0 = cvt_pk_bf16(P[B_+4], P[B_+5]), b1 = cvt_pk_bf16(P[B_+6], P[B_+7]);                                    \
        auto r0 = __builtin_amdgcn_permlane32_swap(a0, b0, false, false); auto r1 = __builtin_amdgcn_permlane32_swap(a1, b1, false, false); \
        u32x4 w = {r0[0], r1[0], r0[1], r1[1]}; OUT = *reinterpret_cast<bf16x8*>(&w); } while (0)
#pragma unroll
    for (int i = 0; i < NP; ++i) { PK4(p[i], 0, pa[2 * i]); PK4(p[i], 8, pa[2 * i + 1]); }
#undef PK4
}
template <int NKS>
__device__ __forceinline__ void pv_step(f32x16 (&o)[4], const bf16x8 (&pa)[NKS], int vb0) {
#define TRRD(dst, off) asm volatile("ds_read_b64_tr_b16 %0, %1 offset:%2" : "=&v"(dst) : "v"(vb0), "i"(off) : "memory")
#define PV_RD(B_, d0) do { TRRD(lo_[B_][0], (d0) * 512); TRRD(hi_[B_][0], (d0) * 512 + 2048); TRRD(lo_[B_][1], (d0) * 512 + 4096); TRRD(hi_[B_][1], (d0) * 512 + 6144);  \
        if constexpr (NKS == 4) { TRRD(lo_[B_][2], (d0) * 512 + 8192); TRRD(hi_[B_][2], (d0) * 512 + 10240); TRRD(lo_[B_][3], (d0) * 512 + 12288); TRRD(hi_[B_][3], (d0) * 512 + 14336); } } while (0)
#define PV_MM(B_, d0) do { _Pragma("unroll") for (int ks = 0; ks < NKS; ++ks)                                                                            \
            o[d0] = __builtin_amdgcn_mfma_f32_32x32x16_bf16(pa[ks], (bf16x8){lo_[B_][ks][0], lo_[B_][ks][1], lo_[B_][ks][2], lo_[B_][ks][3], hi_[B_][ks][0], hi_[B_][ks][1], hi_[B_][ks][2], hi_[B_][ks][3]}, o[d0], 0, 0, 0); } while (0)
#define PV_WAIT(n) do { if constexpr (NKS == 4) { if ((n) != 0) asm volatile("s_waitcnt lgkmcnt(8)" ::: "memory"); else asm volatile("s_waitcnt lgkmcnt(0)" ::: "memory"); }          \
                        else { if ((n) != 0) asm volatile("s_waitcnt lgkmcnt(4)" ::: "memory"); else asm volatile("s_waitcnt lgkmcnt(0)" ::: "memory"); } __builtin_amdgcn_sched_barrier(0); } while (0)
    s16x4 lo_[2][NKS], hi_[2][NKS];
    PV_RD(0, 0);
    PV_RD(1, 1); PV_WAIT(1); PV_MM(0, 0); __builtin_amdgcn_sched_barrier(0);
    PV_RD(0, 2); PV_WAIT(1); PV_MM(1, 1); __builtin_amdgcn_sched_barrier(0);
    PV_RD(1, 3); PV_WAIT(1); PV_MM(0, 2); __builtin_amdgcn_sched_barrier(0);
    PV_WAIT(0); PV_MM(1, 3);
#undef PV_RD
#undef PV_MM
#undef PV_WAIT
#undef TRRD
}
__device__ __forceinline__ void store_o(const f32x16 (&o)[4], float l, unsigned char* mix, size_t tok0, int tstride, int col0, LAS float* xch, int, int) {
    const int lf_ = lane_fresh(), r32 = lf_ & 31, hi = lf_ >> 5;
    asm volatile("" ::: "memory");
    if (hi == 0) xch[32 + r32] = l;
    asm volatile("s_waitcnt lgkmcnt(0)" ::: "memory");
    const int srca = ((4 * (r32 & 7)) + 32 * hi) << 2, dsel = r32 >> 3;
#pragma unroll
    for (int r = 0; r < 16; ++r) { const int rr = crow(r, hi); const float rl = 16.0f * __builtin_amdgcn_rcpf(xch[32 + rr]);
        unsigned char* rowp = mix + (tok0 + (size_t)tstride * rr) * DM + col0;
        int g[4];
#pragma unroll
        for (int d0 = 0; d0 < 4; ++d0) { const float v = o[d0][r] * rl; const float vn = __int_as_float(__builtin_amdgcn_mov_dpp(__float_as_int(v), 0xB1, 0xF, 0xF, true));
            const int pk = __builtin_amdgcn_cvt_pk_fp8_f32(v, vn, 0, false) & 0xffff; const int pk2 = __builtin_amdgcn_mov_dpp(pk, 0x4E, 0xF, 0xF, true);
            g[d0] = __builtin_amdgcn_ds_bpermute(srca, (int)((unsigned)pk | ((unsigned)pk2 << 16))); }
        const int w = dsel == 0 ? g[0] : dsel == 1 ? g[1] : dsel == 2 ? g[2] : g[3];
        *(unsigned*)(rowp + 4 * r32) = (unsigned)w; }
    asm volatile("" ::: "memory");
}

struct CoopSrc { int krow[2], kcol[2], vrow[2], vcol[2]; };
__device__ __forceinline__ void make_ident(bf16x8 (&qb)[2], int l) {
    asm volatile("" : "+v"(l));
    const int r32 = l & 31, j = r32 & 7, on_hi = ((r32 >> 3) & 1) == (l >> 5);
#pragma unroll
    for (int s2 = 0; s2 < 2; ++s2) { const unsigned val = (on_hi && (r32 >> 4) == s2) ? (0x3F80u << (16 * (j & 1))) : 0u; u32x4 w;
#pragma unroll
        for (int k = 0; k < 4; ++k) w[k] = (k == (j >> 1)) ? val : 0u;
        qb[s2] = *reinterpret_cast<bf16x8*>(&w); }
}
template <int MODE>
__device__ __forceinline__ void qk_tile(f32x16 (&p)[2], const bf16x8 (&qr)[8], int tp, int slot, const LAS float* nbl, const int (&kaddr)[4], int hi,
                                        const LAS unsigned char* gtab = nullptr, int nbase = 0, int lane_id = 0, int s2s = 32) {
    if constexpr (MODE == 0) {
#pragma unroll
        for (int g = 0; g < 4; ++g) { const f32x4 b0 = *(const LAS f32x4*)(nbl + tp + 8 * g + 4 * hi), b1 = *(const LAS f32x4*)(nbl + tp + 32 + 8 * g + 4 * hi);
#pragma unroll
            for (int j = 0; j < 4; ++j) { p[0][4 * g + j] = b0[j]; p[1][4 * g + j] = b1[j]; } }
    } else {
#pragma unroll
        for (int r = 0; r < 16; ++r) { p[0][r] = 0.f; p[1][r] = 0.f; }
        bf16x8 qb[2]; make_ident(qb, lane_id);
#pragma unroll
        for (int i = 0; i < 2; ++i)
#pragma unroll
            for (int s2 = 0; s2 < 2; ++s2) { int n0 = nbase + s2s * s2 - 32 * i; n0 = n0 < 0 ? 0 : (n0 > 257 ? 257 : n0);
                const bf16x8 gf = *(const LAS bf16x8*)(gtab + n0 * 16);
                p[i] = __builtin_amdgcn_mfma_f32_32x32x16_bf16(gf, qb[s2], p[i], 0, 0, 0); }
    }
    { int ka_[4];
#pragma unroll
      for (int dd = 0; dd < 4; ++dd) ka_[dd] = kaddr[dd] + slot * 16384;
      bf16x8 kf0[2], kf1[2];
#define QK_RD(B_, d0) do { if ((d0) < 4) { asm volatile("ds_read_b128 %0, %1" : "=&v"(kf0[B_]) : "v"(ka_[(d0) & 3]) : "memory"); asm volatile("ds_read_b128 %0, %1 offset:8192" : "=&v"(kf1[B_]) : "v"(ka_[(d0) & 3]) : "memory"); } \
                           else { asm volatile("ds_read_b128 %0, %1 offset:128" : "=&v"(kf0[B_]) : "v"(ka_[(d0) & 3]) : "memory"); asm volatile("ds_read_b128 %0, %1 offset:8320" : "=&v"(kf1[B_]) : "v"(ka_[(d0) & 3]) : "memory"); } } while (0)
#define QK_MM(B_, d0, n_) do { asm volatile("s_waitcnt lgkmcnt(" #n_ ")" ::: "memory"); __builtin_amdgcn_sched_barrier(0);                                 \
        p[0] = __builtin_amdgcn_mfma_f32_32x32x16_bf16(kf0[B_], qr[d0], p[0], 0, 0, 0); p[1] = __builtin_amdgcn_mfma_f32_32x32x16_bf16(kf1[B_], qr[d0], p[1], 0, 0, 0); __builtin_amdgcn_sched_barrier(0); } while (0)
      QK_RD(0, 0);
      QK_RD(1, 1); QK_MM(0, 0, 2);
      QK_RD(0, 2); QK_MM(1, 1, 2);
      QK_RD(1, 3); QK_MM(0, 2, 2);
      QK_RD(0, 4); QK_MM(1, 3, 2);
      QK_RD(1, 5); QK_MM(0, 4, 2);
      QK_RD(0, 6); QK_MM(1, 5, 2);
      QK_RD(1, 7); QK_MM(0, 6, 2);
      QK_MM(1, 7, 0);
#undef QK_RD
#undef QK_MM
    }
}
template <int MODE>
__device__ __forceinline__ void sm_tile(f32x16 (&p)[2], bf16x8 (&pa)[4], f32x16 (&o)[4], float& m, float& l, int tp, int qpos, int qlo, unsigned wq, const LAS float* tab, LAS float* xch, int r32, int hi) {
    const float NEG = -__builtin_inff(); const int dq = qpos - tp - 4 * hi;
    if constexpr (MODE == 0) {
        if (tp + 63 > qlo) {
#pragma unroll
            for (int r = 0; r < 16; ++r) { const int c = (r & 3) + 8 * (r >> 2); if (c > dq) p[0][r] = NEG; if (c + 32 > dq) p[1][r] = NEG; }
        }
    } else {
        if (tp < 0) {
#pragma unroll
            for (int r = 0; r < 16; ++r) { const int kp = tp + 4 * hi + (r & 3) + 8 * (r >> 2); if (kp < 0) p[0][r] = NEG; if (kp + 32 < 0) p[1][r] = NEG; }
        }
    }
    softmax_step<2>(p, m, l, o, pa, xch, r32, hi);
}
template <int MODE>
__device__ __forceinline__ void coop_tiles(f32x16 (&o)[4], float& m, float& l, bf16x8 (&qr)[8], const bf16_t* Kp, const bf16_t* Vp, int t_first, int n_t, int dir, int pos0, int qpos, int qlo, unsigned wq,
                                           const LAS float* nbl, const LAS float* tab, LAS unsigned char* kbuf, LAS unsigned char* vbuf, const int (&kaddr)[4], int vb00, const CoopSrc& cs,
                                           LAS float* xch, int wid, int r32, int hi, const LAS unsigned char* gtab = nullptr, int nb0 = 0, int t_lo = 0, int t_hi = 1 << 30, int dbg = 0, float bqw = 3e30f) {
#define ISSUE_T(t_, slot_) do { const int lf_ = lane_fresh();           \
        _Pragma("unroll") for (int i = 0; i < 2; ++i) { const int P_ = (2 * wid + i) * 64 + lf_;                                              \
        const int krow_ = P_ >> 4, kcol_ = ((P_ & 15) ^ (krow_ & 7)) * 8;                                                                     \
        const int sb_ = P_ >> 5, kk_ = (sb_ >> 2) * 8 + ((P_ >> 2) & 7), vrow_ = (kk_ & ~0xC) | ((kk_ & 4) << 1) | ((kk_ & 8) >> 1), vcol_ = (sb_ & 3) * 32 + (P_ & 3) * 8; \
        int kp_ = pos0 + 64 * (t_) + krow_; kp_ = kp_ < 0 ? 0 : (kp_ > SEQ - 1 ? SEQ - 1 : kp_);                                              \
        int vp_ = pos0 + 64 * (t_) + vrow_; vp_ = vp_ < 0 ? 0 : (vp_ > SEQ - 1 ? SEQ - 1 : vp_);                                              \
        GLDS16(Kp + (size_t)kp_ * HD + kcol_, kbuf + (slot_) * 16384 + (2 * wid + i) * 1024);                                                 \
        GLDS16(Vp + (size_t)vp_ * HD + vcol_, vbuf + (slot_) * 16384 + (2 * wid + i) * 1024); } } while (0)
    int t_act = 1 << 30;
    if (MODE == 0) t_act = ((qlo + 31 - pos0) >> 6) + 1;
    const bool late = wid >= 4;
    ISSUE_T(t_first, 0);
    if (n_t > 1) ISSUE_T(t_first + dir, 1);
#pragma unroll
    for (int d0 = 0; d0 < 8; ++d0) asm volatile("" : "+v"(qr[d0]));
#define WSTOP(tp_) do { if (MODE == 0 && dir < 0 && (tp_) > 0) wdone = __all(bqw + nbl[(tp_) - 1] < m - 40.0f / C2); } while (0)
    bool wdone = false;
    bf16x8 pa[4]; f32x16 p[2]; int sl = 0; bool prev_on = false; int tp_prev = 0;
    for (int k = 0, t = t_first; k < n_t; ++k, t += dir, sl = (sl + 1) & 3) {
        if (k + 1 < n_t) VMW(4); else VMW(0);
        BAR_LDS();
        if (k + 2 < n_t) ISSUE_T(t + 2 * dir, (sl + 2) & 3);
        if (prev_on) {
            if (late) { sm_tile<MODE>(p, pa, o, m, l, tp_prev, qpos, qlo, wq, tab, xch, r32, hi); WSTOP(tp_prev); }
            pv_step<4>(o, pa, vb00 + ((sl + 3) & 3) * 16384);
        }
        const bool on = MODE == 0 ? (t < t_act && !wdone) : (t >= t_lo && t <= t_hi);
        if (on) {
            const int tp = pos0 + 64 * t;
            qk_tile<MODE>(p, qr, tp, sl, nbl, kaddr, hi, gtab, nb0 - 64 * t, r32 + 32 * hi);
            if (!late) { sm_tile<MODE>(p, pa, o, m, l, tp, qpos, qlo, wq, tab, xch, r32, hi); WSTOP(tp); }
            tp_prev = tp;
        }
        prev_on = on;
    }
    if (prev_on) {
        if (late) sm_tile<MODE>(p, pa, o, m, l, tp_prev, qpos, qlo, wq, tab, xch, r32, hi);
        pv_step<4>(o, pa, vb00 + ((sl + 3) & 3) * 16384);
    }
#undef ISSUE_T
#undef WSTOP
}
__device__ __forceinline__ void coop_setup(CoopSrc& cs, int (&kaddr)[4], LAS unsigned char* kbuf, int wid, int lane, int r32, int hi) {
#pragma unroll
    for (int dd = 0; dd < 4; ++dd) kaddr[dd] = (int)(uintptr_t)kbuf + r32 * 256 + (((2 * dd + hi) ^ (r32 & 7)) << 4);
#pragma unroll
    for (int i = 0; i < 2; ++i) { const int P = (2 * wid + i) * 64 + lane;
        { const int row = P >> 4, c = (P & 15) ^ (row & 7); cs.krow[i] = row; cs.kcol[i] = c * 8; }
        { const int sb = P >> 5, k7 = (P >> 2) & 7, cc = P & 3, kk = (sb >> 2) * 8 + k7, k = (kk & ~0xC) | ((kk & 4) << 1) | ((kk & 8) >> 1); cs.vrow[i] = k; cs.vcol[i] = (sb & 3) * 32 + cc * 8; } }
}

__device__ __forceinline__ void build_gtab(const float* rel_bias, bf16_t* tab, int bid, int nb, int wv_) {
    for (int i = bid * NTHREADS + wv_ * 64 + lane_fresh(); i < NHA * 3 * 258 * 8; i += nb * NTHREADS) {
        const int h = i / (3 * 258 * 8), r = i % (3 * 258 * 8), j = r & 7, e = r >> 3, br = e / 258, n0 = e % 258 - 128;
        const int nn = n0 + j * (br == 0 ? 1 : (16 >> (2 * br)));
        const float v = (nn >= 0 && nn <= 128) ? rel_bias[t5_bucket(nn << (2 * br)) * NHA + h] * RSCALE : -3e30f;
        tab[i] = f2bf(v); }
}
__device__ __forceinline__ void dilated_part(const bf16_t* qkv, const float* rel_bias, unsigned char* mix, LAS unsigned char* lds, int bid, int nb, int wv_) {
    const int wid = wv_; int r32, hi; { const int lf_ = lane_fresh(); r32 = lf_ & 31; hi = lf_ >> 5; }
    LAS unsigned char* kl = lds + wid * 16384;
    LAS unsigned char* kbuf = lds; LAS unsigned char* vbuf = lds + 65536;
    LAS unsigned char* gtab = lds + 131072;
    LAS float* xch = (LAS float*)(lds + 147456) + wid * 64;
    for (int item = bid; item < NBATCH * NHA * 4; item += nb) {
        const int xj = item & 7, xk = item >> 3;
        for (int j4 = 0; j4 < 4; ++j4) {
        const int bh = (xj * 8 + 2 * j4 + (xk >> 4)) & 63, b = bh >> 4, h = bh & 15;
        __syncthreads();
        { const int tg_ = wid * 64 + lane_fresh();
          for (int i = tg_; i < 3 * 258; i += NTHREADS) *(LAS u32x4*)(gtab + i * 16) = *(const u32x4*)((const unsigned char*)rel_bias + (size_t)h * (3 * 258 * 16) + i * 16); }
        const size_t boff = (size_t)b * SEQ;
        const bf16_t* Qp = qkv + ((size_t)(0 + h) * NTOK + boff) * HD; const bf16_t* Kp = qkv + ((size_t)(16 + h) * NTOK + boff) * HD; const bf16_t* Vp = qkv + ((size_t)(32 + h) * NTOK + boff) * HD;
        {
            const int cg = xk & 15, T0 = 8 * (cg & 1) + 512 * (cg >> 1), t0 = T0 + wid;
            bf16x8 qr[8]; f32x16 o[4]; float m = -1e30f, l = 0.f;
            { int lr_ = lane_fresh();
              const int nq = lr_ & 31, qposA = T0 + 64 * wid + 16 * (nq >> 3) + (nq & 7);
#pragma unroll
              for (int d0 = 0; d0 < 8; ++d0) qr[d0] = *(const bf16x8*)(Qp + (size_t)qposA * HD + d0 * 16 + (lr_ >> 5) * 8); }
#pragma unroll
            for (int d0 = 0; d0 < 4; ++d0)
#pragma unroll
                for (int r = 0; r < 16; ++r) o[d0][r] = 0.f;
            __syncthreads();
            { int lo_ = lane_fresh();
              const int r32o = lo_ & 31, hio = lo_ >> 5; int caddr[4]; CoopSrc cs; coop_setup(cs, caddr, kbuf, wid, lo_, r32o, hio);
              const int vb00 = (int)(uintptr_t)vbuf + v_rd_base(lo_);
              const int pos0 = T0 - 128, ts = pos0 < 0 ? ((-pos0) >> 6) : 0;
              coop_tiles<1>(o, m, l, qr, Kp, Vp, ts, 10 - ts, 1, pos0, 0, 0, 0u, nullptr, nullptr, kbuf, vbuf, caddr, vb00, cs, xch, wid, r32, hi, gtab, 64 * wid + 16 * hio + 256 - r32o, wid, wid + 2); }
            __syncthreads();
            const int qpos = t0 + 16 * r32;
            { int lh_ = lane_fresh();
              const int nh = lh_ & 31, hh_ = lh_ >> 5;
#pragma unroll
              for (int d0 = 0; d0 < 8; ++d0) qr[d0] = *(const bf16x8*)(Qp + (size_t)(t0 + 16 * nh) * HD + d0 * 16 + hh_ * 8);
              { LAS float* ob = (LAS float*)lds + 32 * wid * 128 + nh;
#pragma unroll
                for (int d0 = 0; d0 < 4; ++d0)
#pragma unroll
                    for (int r = 0; r < 16; ++r) ob[crow(r, hh_) * 128 + 32 * d0] = o[d0][r];
                if (hh_ == 0) { LAS float* ml = (LAS float*)(lds + 147456); ml[32 * wid + nh] = m; ml[256 + 32 * wid + nh] = l; } }
              __syncthreads();
              { const LAS float* ob = (const LAS float*)lds + wid * 128 + nh;
#pragma unroll
                for (int d0 = 0; d0 < 4; ++d0)
#pragma unroll
                    for (int r = 0; r < 16; ++r) o[d0][r] = ob[8 * crow(r, hh_) * 128 + 32 * d0];
                const LAS float* ml = (const LAS float*)(lds + 147456); m = ml[8 * nh + wid]; l = ml[256 + 8 * nh + wid]; }
#pragma unroll
              for (int d0 = 0; d0 < 8; ++d0) asm volatile("" : "+v"(qr[d0])); }
            __syncthreads();
            {
                const int cls = wid & 3, hh = wid >> 2, kmc = T0 + cls - 512;
                int ts8 = 0; while (ts8 < 3 && T0 + 3 - 512 + 4 * (64 * ts8 + 63) < 0) ++ts8;
                LAS unsigned char* ktl = lds + cls * 16384; LAS unsigned char* vtl = lds + 65536 + cls * 16384;
                int kaddr4[4]; int vb4, nb4;
                { const int lq_ = lane_fresh();
#pragma unroll
                  for (int dd = 0; dd < 4; ++dd) kaddr4[dd] = (int)(uintptr_t)ktl + (lq_ & 31) * 256 + (((2 * dd + (lq_ >> 5)) ^ (lq_ & 7)) << 4);
                  vb4 = (int)(uintptr_t)vtl + v_rd_base(lq_);
                  nb4 = 256 + hh + 32 * (lq_ >> 5) - (lq_ & 31); }
#define ISSUE8K(s_) do { const int l4_ = lane_fresh(); _Pragma("unroll") for (int j = 0; j < 16; ++j) { const int P_ = j * 64 + l4_, row_ = P_ >> 4, col_ = ((P_ & 15) ^ (row_ & 7)) * 8;     \
                    int kp_ = kmc + 4 * (64 * (s_) + row_); kp_ = kp_ < 0 ? 0 : (kp_ > SEQ - 1 ? SEQ - 1 : kp_);                                                       \
                    GLDS16(Kp + (size_t)kp_ * HD + col_, ktl + j * 1024); } } while (0)
#define ISSUE8V(s_) do { const int l4_ = lane_fresh(); _Pragma("unroll") for (int j = 0; j < 16; ++j) { const int P_ = j * 64 + l4_, sb_ = P_ >> 5, kk_ = (sb_ >> 2) * 8 + ((P_ >> 2) & 7);      \
                    const int vrow_ = (kk_ & ~0xC) | ((kk_ & 4) << 1) | ((kk_ & 8) >> 1), vcol_ = (sb_ & 3) * 32 + (P_ & 3) * 8;                                         \
                    int kp_ = kmc + 4 * (64 * (s_) + vrow_); kp_ = kp_ < 0 ? 0 : (kp_ > SEQ - 1 ? SEQ - 1 : kp_);                                                      \
                    GLDS16(Vp + (size_t)kp_ * HD + vcol_, vtl + j * 1024); } } while (0)
                if (hh == 0) ISSUE8K(ts8); else ISSUE8V(ts8);
                for (int s8 = ts8; s8 < 4; ++s8) {
                    if (hh == 0) VMW(0);
                    BAR_LDS();
                    if (hh != 0 && s8 > ts8) ISSUE8V(s8);
                    f32x16 p[2];
                    qk_tile<1>(p, qr, 0, 0, nullptr, kaddr4, hi, gtab + 258 * 16, nb4 - 64 * s8, r32 + 32 * hi, 64);
                    BAR_LDS();
                    if (hh == 0 && s8 + 1 < 4) ISSUE8K(s8 + 1);
                    { const int kp0 = kmc + 256 * s8;
                      if (kp0 < 0) { const float NEG = -__builtin_inff();
#pragma unroll
                          for (int r = 0; r < 16; ++r) { const int kr = kp0 + 4 * (4 * hi + (r & 3) + 8 * (r >> 2)); if (kr < 0) p[0][r] = NEG; if (kr + 128 < 0) p[1][r] = NEG; } } }
                    bf16x8 pa[4];
                    softmax_step<2>(p, m, l, o, pa, xch, r32, hi);
                    if (hh != 0) VMW(0);
                    BAR_LDS();
                    pv_step<4>(o, pa, vb4);
                }
#undef ISSUE8K
#undef ISSUE8V
            }
            __syncthreads();
            {
            int lp_ = lane_fresh();
            const int vb0 = (int)(uintptr_t)kl + v_rd_base(lp_);
            const int kk7 = (lp_ >> 2) & 7, vk0 = (kk7 & 3) + 8 * (kk7 >> 2), vc0 = (lp_ >> 5) * 32 + (lp_ & 3) * 8;
            const int kr32 = lp_ & 31, khi8 = (lp_ >> 5) * 8;
#define BR_KMIN(b_) (t0 - (128 << (2 * (b_))))
#define BR_NT(b_) ((b_) == 1 ? 8 : 5)
#define BR_TS(b_) (BR_KMIN(b_) < 0 ? ((-BR_KMIN(b_)) >> (5 + 2 * (b_))) : 0)
#define LOAD_K(KF, b_, t_) do { int kp_ = BR_KMIN(b_) + ((32 * (t_) + kr32) << (2 * (b_))); kp_ = kp_ < 0 ? 0 : (kp_ > SEQ - 1 ? SEQ - 1 : kp_);          \
                const bf16_t* kr_ = Kp + (size_t)kp_ * HD + khi8; _Pragma("unroll") for (int d0 = 0; d0 < 8; ++d0) KF[d0] = *(const bf16x8*)(kr_ + d0 * 16); } while (0)
#define ISSUE_V(b_, t_, slot_) do { const int km_ = BR_KMIN(b_), ds_ = 2 * (b_); _Pragma("unroll") for (int j = 0; j < 8; ++j) {                       \
                int kp_ = km_ + ((32 * (t_) + vk0 + 4 * ((j >> 1) & 1) + 16 * (j >> 2)) << ds_); kp_ = kp_ < 0 ? 0 : (kp_ > SEQ - 1 ? SEQ - 1 : kp_);   \
                GLDS16(Vp + (size_t)kp_ * HD + vc0 + 64 * (j & 1), kl + (slot_) * 8192 + j * 1024); } } while (0)
#define PSTEP(KC, KN, vs_) do {                                                                                                                          \
                int nb_ = cb, ntl = ct + 1; has_next = true;                                                                                              \
                if (ntl >= BR_NT(cb)) { nb_ = cb + 1; if (nb_ > 2) has_next = false; else ntl = BR_TS(nb_); }                                             \
                if (has_next) { LOAD_K(KN, nb_, ntl); ISSUE_V(nb_, ntl, 1 - (vs_)); VMW(16); } else VMW(0);                                               \
                f32x16 p[1];                                                                                                                              \
                _Pragma("unroll") for (int r = 0; r < 16; ++r) p[0][r] = 0.f;                                                                             \
                { const int qs_ = 16 >> (2 * cb);                                                     \
                  bf16x8 qbp[2]; make_ident(qbp, lane_fresh());                                                                                                   \
                  int lz_ = lane_fresh();                                                                                             \
                  _Pragma("unroll") for (int s2 = 0; s2 < 2; ++s2) { int n0 = 256 + qs_ * (16 * s2 + 8 * (lz_ >> 5)) - (32 * ct + (lz_ & 31)); n0 = n0 < 0 ? 0 : (n0 > 257 ? 257 : n0); \
                      const bf16x8 gf = *(const LAS bf16x8*)(gtab + (cb * 258 + n0) * 16);                                                                  \
                      p[0] = __builtin_amdgcn_mfma_f32_32x32x16_bf16(gf, qbp[s2], p[0], 0, 0, 0); } }                                                       \
                _Pragma("unroll") for (int d0 = 0; d0 < 8; ++d0) p[0] = __builtin_amdgcn_mfma_f32_32x32x16_bf16(KC[d0], qr[d0], p[0], 0, 0, 0);           \
                { const int kp0 = BR_KMIN(cb) + ((32 * ct) << (2 * cb));                                                                                   \
                  if (kp0 < 0) { const float NEG = -__builtin_inff();                                                                                      \
                      _Pragma("unroll") for (int r = 0; r < 16; ++r) if (kp0 + ((4 * hi + (r & 3) + 8 * (r >> 2)) << (2 * cb)) < 0) p[0][r] = NEG; } }     \
                bf16x8 pa[2];                                                                                                                             \
                softmax_step<1>(p, m, l, o, pa, xch, r32, hi);                                                                                            \
                pv_step<2>(o, pa, vb0 + (vs_) * 8192);                                                                                                    \
                cb = nb_; ct = ntl; } while (0)
            int cb = 2, ct = BR_TS(2); bool has_next = true;
            bf16x8 kfA[8], kfB[8];
            LOAD_K(kfA, cb, ct); ISSUE_V(cb, ct, 0);
            for (;;) {
                PSTEP(kfA, kfB, 0); if (!has_next) break;
                PSTEP(kfB, kfA, 1); if (!has_next) break;
            }
#undef PSTEP
#undef LOAD_K
#undef ISSUE_V
#undef BR_KMIN
#undef BR_NT
#undef BR_TS
            }
            store_o(o, l, mix, boff + t0, 16, h * HD, xch, r32, hi);
        }
        }
    }
}

__device__ __forceinline__ void fox_part(const bf16_t* qkv, const float* nbias, const float* gq, const float* gk, unsigned char* mix, LAS unsigned char* lds, int bid, int nb, int wv_, int dbg = 0) {
    const int wid = wv_; int r32, hi; { const int lf_ = lane_fresh(); r32 = lf_ & 31; hi = lf_ >> 5; }
    asm volatile("" : "+s"(gq), "+s"(gk), "+s"(nbias));
    float bq;
    { const int lb_ = lane_fresh(); float a = fmaxf(fabsf(gq[lb_]), fabsf(gq[lb_ + 64])), c = fmaxf(fabsf(gk[lb_]), fabsf(gk[lb_ + 64]));
#pragma unroll
      for (int o_ = 32; o_ >= 1; o_ >>= 1) { a = fmaxf(a, __shfl_xor(a, o_)); c = fmaxf(c, __shfl_xor(c, o_)); }
      bq = 128.0f * 1.02f * a * c; }
    LAS unsigned char* kbuf = lds;
    LAS unsigned char* vbuf = lds + 65536;
    LAS float* nbl = (LAS float*)(lds + 131072);
    LAS float* xch = (LAS float*)(lds + 147456) + wid * 64;
    for (int item = bid; item < NBATCH * NHB * 8; item += nb) {
        const int xj = item & 7, xk = item >> 3, bh = (xj * 8 + (xk >> 3)) & 63, x = (xk & 32) ? 7 - (xk & 7) : (xk & 7), b = bh >> 4, h = bh & 15;
        const size_t boff = (size_t)b * SEQ;
        const bf16_t* Qp = qkv + ((size_t)(48 + h) * NTOK + boff) * HD; const bf16_t* Kp = qkv + ((size_t)(64 + h) * NTOK + boff) * HD; const bf16_t* Vp = qkv + ((size_t)(80 + h) * NTOK + boff) * HD;
        __syncthreads();
        { int ti_ = wid * 64 + lane_fresh();
          const f32x4 n0_ = *(const f32x4*)(nbias + (size_t)bh * SEQ + ti_ * 4), n1_ = *(const f32x4*)(nbias + (size_t)bh * SEQ + (ti_ + NTHREADS) * 4);
          *(LAS f32x4*)(nbl + ti_ * 4) = n0_; *(LAS f32x4*)(nbl + (ti_ + NTHREADS) * 4) = n1_; }
        for (int half = 0; half < 2; ++half) {
            const int qb = half ? 15 - x : x, NT = 4 * (qb + 1), qlo = qb * 256 + wid * 32, qpos = qlo + r32;
            bf16x8 qr[8];
#pragma unroll
            for (int d0 = 0; d0 < 8; ++d0) qr[d0] = *(const bf16x8*)(Qp + (size_t)qpos * HD + d0 * 16 + hi * 8);
            f32x16 o[4]; float m = -1e30f, l = 0.f;
#pragma unroll
            for (int d0 = 0; d0 < 4; ++d0)
#pragma unroll
                for (int r = 0; r < 16; ++r) o[d0][r] = 0.f;
            __syncthreads();
            int lo_ = lane_fresh();
            int kaddr[4]; CoopSrc cs; coop_setup(cs, kaddr, kbuf, wid, lo_, lo_ & 31, lo_ >> 5);
            const int vb00 = (int)(uintptr_t)vbuf + v_rd_base(lo_);
            int t_stop;
            { const float thr = nbl[qb * 256] - 40.0f / C2 - 2.0f * bq; const int tt = lane_fresh(); const bool sk = tt < NT && nbl[64 * tt + 63] < thr;
              t_stop = __builtin_popcountll(__ballot(sk)); if (t_stop > NT - 1) t_stop = NT - 1; }
            coop_tiles<0>(o, m, l, qr, Kp, Vp, NT - 1, NT - t_stop, -1, 0, qpos, qlo, 0u, nbl, nullptr, kbuf, vbuf, kaddr, vb00, cs, xch, wid, r32, hi, nullptr, 0, 0, 1 << 30, dbg, bq);
            store_o(o, l, mix, boff + qb * 256 + wid * 32, 1, (NHA + h) * HD, xch, r32, hi);
        }
    }
}
__device__ __forceinline__ void attn_phase(const bf16_t* qkv, const float* nbias, const float* rel_bias, const float* gq, const float* gk, unsigned char* mix, LAS unsigned char* lds, int bid, int nb, int wv_) {
    dilated_part(qkv, rel_bias, mix, lds, bid, nb, wv_);
    __syncthreads();
    fox_part(qkv, nbias, gq, gk, mix, lds, bid, nb, wv_);
#if ATT_PROBE == 2
    __syncthreads();
    fox_part(qkv, nbias, gq, gk, mix, lds, bid, nb, wv_);
#endif

}
#undef GLDS16
#undef TABIDX
#undef VMW
#undef BAR_LDS
}

namespace peer {
__device__ __forceinline__ void ins16(float (&L)[16], float x) {
#pragma unroll
    for (int k = 15; k >= 1; --k) L[k] = __builtin_amdgcn_fmed3f(L[k - 1], L[k], x);
    L[0] = fmaxf(L[0], x);
}
__device__ __forceinline__ void top16_stream(const float* base, int lane, float (&L)[16]) {
    const float NEG = -__builtin_inff();
#pragma unroll
    for (int k = 0; k < 16; ++k) L[k] = NEG;
#define TK_LOAD(X, j0_) do { _Pragma("unroll") for (int j = 0; j < 16; ++j) X[j] = base[(size_t)((j0_) + j) * 64 + lane]; } while (0)
#define TK_INS(X, j0_) do { _Pragma("unroll") for (int j = 0; j < 16; ++j) ins16(L, __uint_as_float((__float_as_uint(X[j]) & ~127u) | (unsigned)(127 - ((j0_) + j)))); } while (0)
    float xa[16], xb[16];
    TK_LOAD(xa, 0);
    for (int j0 = 0; j0 < 128; j0 += 32) {
        TK_LOAD(xb, j0 + 16);
        TK_INS(xa, j0);
        if (j0 + 32 < 128) TK_LOAD(xa, j0 + 32);
        TK_INS(xb, j0 + 16);
    }
#undef TK_LOAD
#undef TK_INS
}
__device__ __forceinline__ void topk_phase(const float* sct, unsigned char* gd, float* gatec, int* ec, LAS unsigned char* lds, int bid, int nb, int wv_) {
    const int tid = TIDX, wid = wv_, lane = tid & 63;
    LAS int* ent_e = (LAS int*)lds; LAS float* ent_g = (LAS float*)(lds + 64 * 129 * 4);
#pragma unroll
    for (int k = 0; k < 8; ++k) ((LAS unsigned*)(lds + 74240))[wid * 512 + k * 64 + lane] = 0u;
    for (int tile = bid; tile < NTOK / 64; tile += nb) {
        float L1[16], L2[16];
        top16_stream(sct + (size_t)((wid * 2 + 0) * 256 + tile) * 128 * 64, lane, L1);
        top16_stream(sct + (size_t)((wid * 2 + 1) * 256 + tile) * 128 * 64, lane, L2);
        LAS unsigned char* ix1 = lds + 90624 + tid; LAS unsigned char* ix2 = ix1 + 8192;
#pragma unroll
        for (int k = 0; k < 16; ++k) { ix1[k * 512] = (unsigned char)(127u - (__float_as_uint(L1[k]) & 127u)); ix2[k * 512] = (unsigned char)(127u - (__float_as_uint(L2[k]) & 127u)); }
        float Cv[16];
#pragma unroll
        for (int k = 0; k < 16; ++k) Cv[k] = -__builtin_inff();
#pragma unroll
        for (int i = 0; i < 16; ++i)
#pragma unroll
            for (int j = 0; j < 16; ++j) if ((i + 1) * (j + 1) <= 16)
                ins16(Cv, __uint_as_float((__float_as_uint(L1[i] + L2[j]) & ~255u) | (unsigned)(16 * i + j)));
        int Ce[16];
#pragma unroll
        for (int k = 0; k < 16; ++k) { const unsigned id = __float_as_uint(Cv[k]) & 255u; Ce[k] = (int)ix1[(id >> 4) * 512] * NKEYS + (int)ix2[(id & 15u) * 512]; }
        float ex[16], den = 0.f;
#pragma unroll
        for (int k = 0; k < 16; ++k) { ex[k] = __expf(Cv[k] - Cv[0]); den += ex[k]; }
        const float rden = 1.0f / den;
#pragma unroll
        for (int k = 0; k < 16; ++k) { ent_e[lane * 129 + wid * 16 + k] = Ce[k]; ent_g[lane * 129 + wid * 16 + k] = ex[k] * rden; }
        __syncthreads();
        LAS unsigned char* own = lds + 66048;
        LAS unsigned* bm = (LAS unsigned*)(lds + 74240) + wid * 512;
        for (int tt = 0; tt < 8; ++tt) {
            const int tl = wid * 8 + tt; const LAS int* ee = ent_e + tl * 129; const LAS float* gg = ent_g + tl * 129;
            const int ea = ee[lane], eb = ee[lane + 64]; float ga = 0.f, gb = 0.f; bool oa = true, ob = true;
            const unsigned fa = __hip_atomic_fetch_or(bm + (ea >> 5), 1u << (ea & 31), __ATOMIC_RELAXED, __HIP_MEMORY_SCOPE_WORKGROUP);
            const unsigned fb = __hip_atomic_fetch_or(bm + (eb >> 5), 1u << (eb & 31), __ATOMIC_RELAXED, __HIP_MEMORY_SCOPE_WORKGROUP);
            const bool dup = (((fa >> (ea & 31)) | (fb >> (eb & 31))) & 1u) != 0u;
            asm volatile("s_waitcnt lgkmcnt(0)" ::: "memory");
            bm[ea >> 5] = 0u; bm[eb >> 5] = 0u;
            if (!__any(dup)) { ga = gg[lane]; gb = gg[lane + 64]; }
            else
            for (int j = 0; j < 128; ++j) { const int ej = ee[j]; const float gj = gg[j];
                if (ej == ea) { if (j < lane) oa = false; ga += gj; }
                if (ej == eb) { if (j < lane + 64) ob = false; gb += gj; } }
            const size_t trow = (size_t)(tile * 64 + tl);
            own[tl * 128 + lane] = oa ? (unsigned char)(lane + 1) : (unsigned char)0;
            own[tl * 128 + lane + 64] = ob ? (unsigned char)(lane + 65) : (unsigned char)0;
            gatec[trow * 128 + lane] = oa ? ga : 0.f; gatec[trow * 128 + lane + 64] = ob ? gb : 0.f;
            ec[trow * 128 + lane] = ea; ec[trow * 128 + lane + 64] = eb;
        }
        __syncthreads();
        { LAS unsigned char* img = lds + 90624; const int pm = tile >> 2, q4 = tile & 3, ai = q4 >> 1, wr = q4 & 1;
#pragma unroll
          for (int i = 0; i < 8; ++i) *(LAS u32x4*)(img + (tid + NTHREADS * i) * 16) = (u32x4){0u, 0u, 0u, 0u};
          __syncthreads();
          int epk[16];
#pragma unroll
          for (int k2 = 0; k2 < 16; ++k2) { const int idx = tid + NTHREADS * k2, tl = idx >> 7, sl = idx & 127; const unsigned b = own[idx]; const int e = ent_e[tl * 129 + sl];
              const int pnl = (e >> 8) & 3, col = e & 255, m = (tl >> 4) & 3, fr = tl & 15;
              const int off = ((((pnl * 4 + m) * 2 + (col >> 7)) * 4 + ((col >> 5) & 3)) << 9) + fr * 32 + (col & 31);
              epk[k2] = b != 0u ? (((e >> 10) << 24) | (off << 8) | (int)b) : -1; }
          for (int p = 0; p < 16; ++p) {
#pragma unroll
              for (int k2 = 0; k2 < 16; ++k2) if ((epk[k2] >> 24) == p) img[(epk[k2] >> 8) & 0xffff] = (unsigned char)(epk[k2] & 0xff);
              __syncthreads();
#pragma unroll
              for (int i = 0; i < 8; ++i) { const int P = tid + NTHREADS * i, c = P >> 5, wc = c & 3, bj = (c >> 2) & 1, m = (c >> 3) & 3, pnl = c >> 5;
                  unsigned char* dst = gd + (size_t)(pm * 64 + 4 * p + pnl) * 65536 + (size_t)(((ai * 4 + m) * 2 + bj) * 4096 + (wr * 4 + wc) * 512 + (P & 31) * 16);
                  *(u32x4*)dst = *(const LAS u32x4*)(img + P * 16); *(LAS u32x4*)(img + P * 16) = (u32x4){0u, 0u, 0u, 0u}; }
              __syncthreads();
          } }
    }
}
__device__ __forceinline__ void act_phase(const float* pre, const float* gatec, const int* ec, unsigned char* gd, int bid, int nb, int wv_) {
    const size_t st = (size_t)nb * NTHREADS, n = (size_t)NTOK * 128; size_t i = (size_t)bid * NTHREADS + TIDX;
    for (; i + 7 * st < n; i += 8 * st) {
        float gt[8], pr[8]; int ee[8];
#pragma unroll
        for (int q = 0; q < 8; ++q) { gt[q] = gatec[i + q * st]; pr[q] = pre[i + q * st]; ee[q] = ec[i + q * st]; }
#pragma unroll
        for (int q = 0; q < 8; ++q) if (gt[q] != 0.f) { const float a = pg8::gelu1(pr[q]) * gt[q] * 16.0f;
            gd[pg8::gd_off((int)((i + q * st) >> 7), ee[q])] = (unsigned char)(__builtin_amdgcn_cvt_pk_fp8_f32(a, 0.f, 0, false) & 0xff); }
    }
    for (; i < n; i += st) {
        const float gt = gatec[i];
        if (gt != 0.f) { const float a = pg8::gelu1(pre[i]) * gt * 16.0f;
            gd[pg8::gd_off((int)(i >> 7), ec[i])] = (unsigned char)(__builtin_amdgcn_cvt_pk_fp8_f32(a, 0.f, 0, false) & 0xff); }
    }
}
}

__global__ void __launch_bounds__(NTHREADS, 2) hybrid_fwd(Args args) {
    extern __shared__ __attribute__((aligned(16))) unsigned char lds_raw[];
    LAS unsigned char* lds = (LAS unsigned char*)lds_raw;
    const int wv_ = __builtin_amdgcn_readfirstlane((int)threadIdx.x >> 6); const int bid = blockIdx.x, nb = gridDim.x;
    unsigned char* ws = args.ws;
    { const int tid = TIDX; if (tid < 4) ((LAS unsigned*)(lds + LDS_BARW))[tid] = 0u; }
    __syncthreads();
    XcdBarrier bar; bar.bar = (unsigned*)(ws + WS_CTL); bar.x = 0; bar.st = nullptr;
    const int lo = args.ph_lo, hi = args.ph_hi;
    if (hi - lo > 1) bar = xcd_barrier_post((unsigned*)(ws + WS_CTL) + args.bar_idx * XCD_BAR_WORDS, (volatile LAS unsigned*)(lds + LDS_BARW), wv_);
#ifndef PHASE_MASK
#define PHASE_MASK 0x7ff
#endif
#define IN(k) (((PHASE_MASK >> (k)) & 1) && lo <= (k) && (k) < hi)
#define SEAM(k) do { if (IN(k) && IN((k) + 1)) xcd_barrier(bar, wv_); } while (0)
    float* mod = (float*)(ws + WS_MOD);
    bf16_t* H = (bf16_t*)(ws + WS_H);
    bf16_t* QKV = (bf16_t*)(ws + WS_QKV);
    unsigned char* GD = ws + WS_QKV;

    if (IN(0)) { p0_prologue(args, lds, bid, nb, wv_); }
    SEAM(0);
    if (IN(1)) { norm_phase<true, true, false>(karg_in(0), karg_in(4), mod + 0 * DM, mod + 1 * DM, nullptr, ws + WS_H8, (const bf16_t*)(ws + WS_WFZT), karg_in(6), (float*)(ws + WS_LOGF), lds, bid, nb, wv_); }
    SEAM(1);
    if (IN(2)) {
        att2::build_gtab(karg_in(11), (bf16_t*)(ws + WS_GTAB), bid, nb, wv_);
        cumsum_phase((const float*)(ws + WS_LOGF), (float*)(ws + WS_NB), lds + LDS_AUX, bid, nb, wv_);
        pg8::Gemm g{(const bf16_t*)(ws + WS_H8), (const bf16_t*)(ws + WS_WINT), NTOK, NQKV, DM}; pg8::StaticOrder S; S.init(NTOK, NQKV, nb, bid);
        pg8::EpiQKV E{QKV, karg_in(7), karg_in(8), karg_in(9), karg_in(10), (LAS float*)(lds + LDS_AUX), 0.015625f};
        pg8::gemm_phase<pg8::EpiQKV, pg8::StaticOrder, true, true, 1>(lds, g, S, E, wv_);
    }
    SEAM(2);
    if (IN(3)) { att2::attn_phase(QKV, (const float*)(ws + WS_NB), (const float*)(ws + WS_GTAB), karg_in(9), karg_in(10), ws + WS_H8, lds, bid, nb, wv_); }
    SEAM(3);
    if (IN(4)) {
        pg8::Gemm g{(const bf16_t*)(ws + WS_H8), (const bf16_t*)(ws + WS_WOT), NTOK, DM, DM}; pg8::StaticOrder S; S.init(NTOK, DM, nb, bid);
        pg8::EpiResid<false, true> E{karg_in(0), ws + WS_X1, mod + 2 * DM, 1.0f / 1024.0f};
        pg8::gemm_phase<pg8::EpiResid<false, true>, pg8::StaticOrder, true, true, 1>(lds, g, S, E, wv_);
    }
    SEAM(4);
    if (IN(5)) {
        norm_phase<false, true, true, false, true>(ws + WS_X1, karg_in(13), mod + 3 * DM, mod + 4 * DM, H, ws + WS_H8, nullptr, nullptr, nullptr, lds, bid, nb, wv_);
    }
    SEAM(5);
    if (IN(6)) {
        pg8::Gemm g{H, (const bf16_t*)(ws + WS_WCT), NTOK, NSC, DM}; pg8::StaticOrder S; S.init(NTOK, NSC, nb, bid);
        pg8::EpiScoreT E{(float*)(ws + WS_SC)};
        pg8::gemm_phase<pg8::EpiScoreT, pg8::StaticOrder, true, true>(lds, g, S, E, wv_);
    }
    SEAM(6);
    if (IN(7)) {
        { u32x4* z = (u32x4*)(ws + WS_PRE); const size_t n16 = (size_t)NTOK * 128 * 4 / 16;
          for (size_t i = (size_t)bid * NTHREADS + TIDX; i < n16; i += (size_t)nb * NTHREADS) z[i] = (u32x4){0u, 0u, 0u, 0u}; }
        peer::topk_phase((const float*)(ws + WS_SC), GD, (float*)(ws + WS_GATEC), (int*)(ws + WS_EC), lds, bid, nb, wv_);
    }
    SEAM(7);
    if (IN(8)) {
        pg8::Gemm g{(const bf16_t*)(ws + WS_H8), (const bf16_t*)(ws + WS_UB), NTOK, NEXP, DM}; pg8::StaticOrder S; S.init(NTOK, NEXP, nb, bid);
        pg8::EpiSlot E{GD, NEXP, 0.015625f, (float*)(ws + WS_PRE)};
        pg8::gemm_phase<pg8::EpiSlot, pg8::StaticOrder, true, true, 1>(lds, g, S, E, wv_);
    }
    SEAM(8);
    if (IN(9)) { peer::act_phase((const float*)(ws + WS_PRE), (const float*)(ws + WS_GATEC), (const int*)(ws + WS_EC), GD, bid, nb, wv_); }
    SEAM(9);
    if (IN(10)) {
        pg8::Gemm g{(const bf16_t*)GD, (const bf16_t*)(ws + WS_VT), NTOK, DM, NEXP}; pg8::StaticOrder S; S.init(NTOK, DM, nb, bid);
        pg8::EpiResid<true, false> E{ws + WS_X1, (float*)karg_in(19), mod + 5 * DM, 0.0625f};
        pg8::gemm_phase<pg8::EpiResid<true, false>, pg8::StaticOrder, true, true, 1, true>(lds, g, S, E, wv_);
    }
#undef IN
#undef SEAM
}

#if ATT_PROBE == 6
__global__ void __launch_bounds__(NTHREADS, 2) fox_probe(Args args) {
    extern __shared__ __attribute__((aligned(16))) unsigned char lds_raw2[];
    LAS unsigned char* lds = (LAS unsigned char*)lds_raw2;
    const int wv_ = __builtin_amdgcn_readfirstlane((int)threadIdx.x >> 6); unsigned char* ws = args.ws;
    att2::fox_part((const bf16_t*)(ws + WS_QKV), (const float*)(ws + WS_NB), args.in[9], args.in[10], ws + WS_SC, lds, blockIdx.x, gridDim.x, wv_, FOXDBG);
}
#endif
extern "C" void kernel_launch(void* const* d_in, const int* in_sizes, int n_in, void* d_out, int out_size, void* d_ws, size_t ws_size, hipStream_t stream) {
    static int grid = 0;
    if (grid == 0) {
        if (n_in != 19 || out_size != NTOK * DM || ws_size < WS_END) { fprintf(stderr, "kernel_launch: unexpected shapes (n_in %d, out %d, ws %zu < %zu)\n", n_in, out_size, ws_size, (size_t)WS_END); grid = -1; return; }
        int dev = 0, cus = 0, per_cu = 0;
        if (hipGetDevice(&dev) != hipSuccess || hipDeviceGetAttribute(&cus, hipDeviceAttributeMultiprocessorCount, dev) != hipSuccess) { grid = -1; return; }
        if (hipFuncSetAttribute((const void*)hybrid_fwd, hipFuncAttributeMaxDynamicSharedMemorySize, LDS_BYTES) != hipSuccess) { fprintf(stderr, "kernel_launch: hipFuncSetAttribute failed\n"); grid = -1; return; }
        if (hipOccupancyMaxActiveBlocksPerMultiprocessor(&per_cu, (const void*)hybrid_fwd, NTHREADS, LDS_BYTES) != hipSuccess || per_cu < 1) { fprintf(stderr, "kernel_launch: occupancy query says %d\n", per_cu); per_cu = 1; }
        (void)hipGetLastError();
        grid = cus;
    }
    if (grid < 0) return;
    (void)hipMemsetAsync((char*)d_ws + WS_CTL, 0, CTL_ZERO_BYTES, stream);
    Args a{};
    for (int i = 0; i < 19; ++i) a.in[i] = (const float*)d_in[i];
    a.out = (float*)d_out; a.ws = (unsigned char*)d_ws;
#ifndef PROBE_PHASES
#define PROBE_PHASES 0
#endif
    int start = 0, nl = 0;
    for (int k = 0; k < 11; ++k) if ((PROBE_PHASES >> k) & 1) {
        a.ph_lo = start; a.ph_hi = k + 1; a.bar_idx = (k + 1 - start > 1) ? nl++ : 0; hipLaunchKernelGGL(hybrid_fwd, dim3(grid), dim3(NTHREADS), LDS_BYTES, stream, a);
        a.ph_lo = k; a.ph_hi = k + 1; a.bar_idx = 0; hipLaunchKernelGGL(hybrid_fwd, dim3(grid), dim3(NTHREADS), LDS_BYTES, stream, a);
        start = k + 1; }
    if (start < 11) { a.ph_lo = start; a.ph_hi = 11; a.bar_idx = nl++ & 3; hipLaunchKernelGGL(hybrid_fwd, dim3(grid), dim3(NTHREADS), LDS_BYTES, stream, a); }
#if ATT_PROBE == 6
    { static bool once = false; if (!once) { once = true; (void)hipFuncSetAttribute((const void*)fox_probe, hipFuncAttributeMaxDynamicSharedMemorySize, LDS_BYTES); }
      a.pad = FOXDBG; hipLaunchKernelGGL(fox_probe, dim3(grid), dim3(NTHREADS), LDS_BYTES, stream, a); }
#endif
}
```

```cpp
#include <hip/hip_runtime.h>
#include <cstdio>
#include <cstdint>

#define LAS __attribute__((address_space(3)))
typedef unsigned short bf16_t;
typedef short bf16x8 __attribute__((ext_vector_type(8)));
typedef short s16x4 __attribute__((ext_vector_type(4)));
typedef float f32x4 __attribute__((ext_vector_type(4)));
typedef float f32x2 __attribute__((ext_vector_type(2)));
typedef float f32x16 __attribute__((ext_vector_type(16)));
typedef unsigned u32x4 __attribute__((ext_vector_type(4)));
typedef unsigned u32x2 __attribute__((ext_vector_type(2)));
typedef int i32x8 __attribute__((ext_vector_type(8)));
typedef int i32x4 __attribute__((ext_vector_type(4)));
typedef int i32x2 __attribute__((ext_vector_type(2)));
typedef int i32x6 __attribute__((ext_vector_type(6)));
typedef unsigned u32x16 __attribute__((ext_vector_type(16)));
typedef __bf16 bf16x32 __attribute__((ext_vector_type(32)));

constexpr int DM = 4096, NBATCH = 4, SEQ = 4096, NTOK = NBATCH * SEQ, HD = 128, NHA = 16, NHB = 16;
constexpr int NQKV = 12288, INC = 12304, NMOD = 6 * DM;
constexpr int PHEADS = 8, NKEYS = 128, NEXP = 16384, TOPK = 16, NSC = PHEADS * 2 * NKEYS;
constexpr float NORM_EPS = 1e-6f;
constexpr int NTHREADS = 512;
constexpr int LDS_RING = 131072, LDS_AUX = 131072, LDS_BYTES = 163840;
constexpr int LDS_BARW = LDS_BYTES - 64;

constexpr size_t WS_CTL = 0;
constexpr size_t WS_MOD = 65536;
constexpr size_t WS_LOGF = WS_MOD + 393216;
constexpr size_t WS_NB = WS_LOGF + 1048576;
constexpr size_t WS_WFZT = WS_NB + 1048576;
constexpr size_t WS_GTAB = WS_WFZT + 131072;
constexpr size_t WS_H = 4194304;
constexpr size_t WS_WINT = WS_H + 134217728;
constexpr size_t WS_WOT = WS_WINT + 100663296;
constexpr size_t WS_WCT = WS_WOT + 33554432;
constexpr size_t WS_UB = WS_WCT + 16777216;
constexpr size_t WS_VT = WS_UB + 134217728;
constexpr size_t WS_QKV = WS_VT + 134217728;
constexpr size_t WS_SC = WS_QKV + 536870912;
constexpr size_t WS_H8 = WS_SC + 134217728;
constexpr size_t WS_X1 = WS_H8 + 67108864;
constexpr size_t WS_PRE = WS_X1 + 134217728;
constexpr size_t WS_GATEC = WS_PRE + 8388608;
constexpr size_t WS_EC = WS_GATEC + 8388608;
constexpr size_t WS_END = WS_EC + 8388608;
constexpr size_t CTL_ZERO_BYTES = 65536;

struct Args { const float* in[19]; float* out; unsigned char* ws; int ph_lo, ph_hi, bar_idx, pad; };
__device__ __forceinline__ int lane_fresh() { int z = 0; asm volatile("" : "+s"(z)); return (int)__builtin_amdgcn_mbcnt_hi(~0u, __builtin_amdgcn_mbcnt_lo(~0u, (unsigned)z)); }
#define TIDX (wv_ * 64 + lane_fresh())
typedef const __attribute__((address_space(4))) unsigned char* KargP;
__device__ __forceinline__ const float* karg_in(int k) {
    KargP p = (KargP)__builtin_amdgcn_kernarg_segment_ptr(); asm volatile("" : "+s"(p));
    return *(const float* const __attribute__((address_space(4)))*)(p + 8 * k);
}

__device__ __forceinline__ unsigned cvt_pk_bf16(float lo, float hi) { unsigned r; asm volatile("v_cvt_pk_bf16_f32 %0, %1, %2" : "=v"(r) : "v"(lo), "v"(hi)); return r; }
__device__ __forceinline__ u32x2 pack8_fp8(f32x4 a, f32x4 b) { int w0 = __builtin_amdgcn_cvt_pk_fp8_f32(a[0], a[1], 0, false); w0 = __builtin_amdgcn_cvt_pk_fp8_f32(a[2], a[3], w0, true);
    int w1 = __builtin_amdgcn_cvt_pk_fp8_f32(b[0], b[1], 0, false); w1 = __builtin_amdgcn_cvt_pk_fp8_f32(b[2], b[3], w1, true); u32x2 r; r.x = (unsigned)w0; r.y = (unsigned)w1; return r; }
__device__ __forceinline__ void store_fp6_slot(unsigned char* ktile_row, int g, i32x6 pk) {
    *(i32x4*)(ktile_row + 16 * g) = (i32x4){pk[0], pk[1], pk[2], pk[3]}; *(i32x2*)(ktile_row + 64 + 16 * g) = (i32x2){pk[4], pk[5]}; }
__device__ __forceinline__ float bf2f(bf16_t b) { return __uint_as_float(((unsigned)b) << 16); }
__device__ __forceinline__ bf16_t f2bf(float f) { return (bf16_t)(cvt_pk_bf16(f, 0.f) & 0xffffu); }

#define XB_TMO      128
#define XB_XCNT(j)  (256  + 64 * (j))
#define XB_XSUB(j)  (1280 + 64 * (j))
#define XB_XGEN(j)  (2304 + 64 * (j))
#define XB_TOP      3328
#define XB_TOPGEN   3392
#define XCD_BAR_WORDS 3456
#define XB_SPIN_CAP (1u << 22)

__device__ __forceinline__ unsigned xb_ld(unsigned* p)              { return __hip_atomic_load(p, __ATOMIC_RELAXED, __HIP_MEMORY_SCOPE_AGENT); }
__device__ __forceinline__ unsigned xb_add(unsigned* p, unsigned v) { return __hip_atomic_fetch_add(p, v, __ATOMIC_RELAXED, __HIP_MEMORY_SCOPE_AGENT); }
__device__ __forceinline__ unsigned xb_xcc_id() { return (unsigned)__builtin_amdgcn_s_getreg((3 << 11) | 20) & 0xFu; }
#define XB_SPIN(cond, bar) do { unsigned _sp = 0; while (cond) { __builtin_amdgcn_s_sleep(1); \
    if ((++_sp & 255u) == 0u) { if (xb_ld(&(bar)[XB_TMO])) break; if (_sp > XB_SPIN_CAP) { atomicAdd(&(bar)[XB_TMO], 1u); break; } } } } while (0)

struct XcdBarrier { unsigned* bar; unsigned x; volatile LAS unsigned* st; };

__device__ __forceinline__ XcdBarrier xcd_barrier_post(unsigned* bar, volatile LAS unsigned* st, int wv_) {
    XcdBarrier b; b.bar = bar; b.x = xb_xcc_id(); b.st = st;
    if (wv_ == 0 && lane_fresh() == 0) (void)xb_add(&bar[XB_XCNT(b.x)], 1u);
    return b;
}
__device__ __forceinline__ void xcd_barrier_complete(unsigned* bar, unsigned x, unsigned& nloc, unsigned& nx) {
    const unsigned G = gridDim.x * gridDim.y * gridDim.z;
    unsigned sum, cnt, mine, sp = 0u;
    for (;;) {
        sum = 0u; cnt = 0u; mine = 0u;
#pragma unroll
        for (unsigned j = 0; j < 16; ++j) { const unsigned c = xb_ld(&bar[XB_XCNT(j)]); sum += c; cnt += (c > 0u) ? 1u : 0u; mine = (j == x) ? c : mine; }
        if (sum == G) break;
        __builtin_amdgcn_s_sleep(1);
        if ((++sp & 255u) == 0u) { if (xb_ld(&bar[XB_TMO])) break; if (sp > XB_SPIN_CAP) { atomicAdd(&bar[XB_TMO], 1u); break; } }
    }
    nloc = mine > 0u ? mine : 1u; nx = cnt > 0u ? cnt : 1u;
}
__device__ __forceinline__ void xcd_barrier(const XcdBarrier& b, int wv_) {
    asm volatile("s_waitcnt vmcnt(0)" ::: "memory");
    __syncthreads();
    if (wv_ == 0 && lane_fresh() == 0) {
        unsigned* bar = b.bar;
        __builtin_amdgcn_s_waitcnt(0);
        unsigned nloc = b.st[0], nx = b.st[1];
        if (nloc == 0u) { xcd_barrier_complete(bar, b.x, nloc, nx); b.st[0] = nloc; b.st[1] = nx; }
        const unsigned old = xb_add(&bar[XB_XSUB(b.x)], 1u);
        const unsigned gen = old / nloc;
        if (old + 1u == (gen + 1u) * nloc) {
            __builtin_amdgcn_fence(__ATOMIC_RELEASE, "agent");
            asm volatile("s_waitcnt vmcnt(0)" ::: "memory");
            const unsigned og = xb_add(&bar[XB_TOP], 1u);
            const unsigned tg = og / nx;
            if (og + 1u == (tg + 1u) * nx) xb_add(&bar[XB_TOPGEN], 1u);
            else XB_SPIN(xb_ld(&bar[XB_TOPGEN]) == tg, bar);
            __builtin_amdgcn_fence(__ATOMIC_ACQUIRE, "agent");
            xb_add(&bar[XB_XGEN(b.x)], 1u);
            asm volatile("s_waitcnt vmcnt(0)" ::: "memory");
        } else {
            XB_SPIN(xb_ld(&bar[XB_XGEN(b.x)]) == gen, bar);
            __builtin_amdgcn_fence(__ATOMIC_ACQUIRE, "agent");
            asm volatile("s_waitcnt vmcnt(0)" ::: "memory");
        }
    }
    __syncthreads();
}

namespace pg8 {
constexpr int BM = 256, BK = 64, HALF = 128, HTB = HALF * BK * 2, STAGE_BYTES = 8 * HTB, NXCD = 8, WGM = 4;
__host__ __device__ __forceinline__ int lds_byte(int r, int c) { const int st = (r >> 4) * 2 + (c >> 5), rr = r & 15, cc = c & 31, ob = rr * 64 + cc * 2; return st * 1024 + (ob ^ (((ob >> 9) & 1) << 5)); }
__host__ __device__ __forceinline__ void stage_rc(int b, int& R, int& C) { const int st = b / 1024, sb = b % 1024, swz = sb ^ (((sb >> 9) & 1) << 5); R = (st >> 1) * 16 + swz / 64; C = (st & 1) * 32 + (swz % 64) / 2; }
__host__ __device__ __forceinline__ int perm32(int rho) { const int n = rho >> 4, i = rho & 15; return 8 * (i >> 2) + 4 * n + (i & 3); }

struct Unit { int pm, pn; };
struct Gemm { const bf16_t* A; const bf16_t* Bt; int M, N, K; };

struct StaticOrder {
    int nM, nN, nwg, G, c;
    __host__ __device__ void init(int M, int N, int G_, int c_) { nM = M / BM; nN = N / BM; nwg = nM * nN; G = G_; c = c_; }
    __host__ __device__ bool next(int i, Unit& u) const {
        const long L = (long)i * G + c; if (L >= nwg) return false;
        int wgid = (int)L; { const int q = nwg / NXCD, r = nwg % NXCD, xcd = wgid % NXCD, off = wgid / NXCD; wgid = (xcd < r ? xcd * (q + 1) : r * (q + 1) + (xcd - r) * q) + off; }
        const int nig = WGM * nN, gid = wgid / nig, fm = gid * WGM, gsz = (nM - fm) < WGM ? (nM - fm) : WGM;
        u.pm = fm + ((wgid % nig) % gsz); u.pn = (wgid % nig) / gsz; return true;
    }
    __device__ __forceinline__ void a_ready(const Unit&) const {}
    __device__ __forceinline__ void done(const Unit&) const {}
};

__device__ __forceinline__ f32x2 gelu_pk(f32x2 v) {
    const f32x2 av = __builtin_elementwise_abs(v), d = av * 0.2316418882f + 1.0f;
    f32x2 t; t.x = __builtin_amdgcn_rcpf(d.x); t.y = __builtin_amdgcn_rcpf(d.y);
    f32x2 q = t * 0.5307027145f + (-0.7265760135f); q = q * t + 0.7107068705f; q = q * t + (-0.142248368f); q = q * t + 0.127414796f; q = q * t;
    const f32x2 s = (v * v) * (-0.72134752044f);
    f32x2 e; e.x = __builtin_amdgcn_exp2f(s.x); e.y = __builtin_amdgcn_exp2f(s.y);
    const f32x2 m = v * (q * e), r = v - m;
    f32x2 o; o.x = v.x < 0.f ? m.x : r.x; o.y = v.y < 0.f ? m.y : r.y; return o;
}

__device__ __forceinline__ float gelu1(float v) {
    const float av = __builtin_fabsf(v), t = __builtin_amdgcn_rcpf(av * 0.2316418882f + 1.0f);
    float q = t * 0.5307027145f + (-0.7265760135f); q = q * t + 0.7107068705f; q = q * t + (-0.142248368f); q = q * t + 0.127414796f; q = q * t;
    const float e = __builtin_amdgcn_exp2f((v * v) * (-0.72134752044f)), m = v * (q * e);
    return v < 0.f ? m : v - m;
}

struct EpiQKV {
    static constexpr bool PERM = true, AFTER_DRAIN = false;
    bf16_t* O; const float* gqa; const float* gka; const float* gqb; const float* gkb; LAS float* P; float scale;
    __device__ __forceinline__ void operator()(f32x4 (&acc)[2][2][4][2], const Unit& u, int wr, int wc, int fr, int fq) const {
        const int grp = u.pn >> 3;
        const float* gain = grp == 0 ? gqa : grp == 1 ? gka : grp == 3 ? gqb : grp == 4 ? gkb : nullptr;
#pragma unroll
        for (int ai = 0; ai < 2; ++ai)
#pragma unroll
            for (int bj = 0; bj < 2; ++bj)
#pragma unroll
                for (int m = 0; m < 4; ++m)
#pragma unroll
                    for (int n = 0; n < 2; ++n) acc[ai][bj][m][n] = acc[ai][bj][m][n] * scale;
        if (gain) {
#pragma unroll
            for (int ai = 0; ai < 2; ++ai)
#pragma unroll
                for (int m = 0; m < 4; ++m)
#pragma unroll
                    for (int bj = 0; bj < 2; ++bj) {
                        const f32x4 a = acc[ai][bj][m][0], b = acc[ai][bj][m][1];
                        float s = (a[0] * a[0] + a[1] * a[1]) + (a[2] * a[2] + a[3] * a[3]) + (b[0] * b[0] + b[1] * b[1]) + (b[2] * b[2] + b[3] * b[3]);
                        s += __shfl_xor(s, 16); s += __shfl_xor(s, 32);
                        if (fq == 0) P[((ai * HALF + wr * 64 + m * 16 + fr) * 2 + bj) * 4 + wc] = s;
                    }
            asm volatile("s_waitcnt lgkmcnt(0)" ::: "memory"); __builtin_amdgcn_s_barrier(); asm volatile("" ::: "memory");
            f32x4 g0 = *(const f32x4*)(gain + wc * 32 + 8 * fq), g1 = *(const f32x4*)(gain + wc * 32 + 8 * fq + 4);
#pragma unroll
            for (int ai = 0; ai < 2; ++ai)
#pragma unroll
                for (int m = 0; m < 4; ++m)
#pragma unroll
                    for (int bj = 0; bj < 2; ++bj) {
                        const f32x4 pp = *(const LAS f32x4*)(P + ((ai * HALF + wr * 64 + m * 16 + fr) * 2 + bj) * 4);
                        const float rinv = __builtin_amdgcn_rsqf(((pp[0] + pp[1]) + (pp[2] + pp[3])) * (1.0f / 128.0f) + NORM_EPS);
                        acc[ai][bj][m][0] = acc[ai][bj][m][0] * rinv * g0; acc[ai][bj][m][1] = acc[ai][bj][m][1] * rinv * g1;
                    }
        }
#pragma unroll
        for (int ai = 0; ai < 2; ++ai)
#pragma unroll
            for (int m = 0; m < 4; ++m) { const size_t row = (size_t)(u.pm * BM + ai * HALF + wr * 64 + m * 16 + fr);
#pragma unroll
                for (int bj = 0; bj < 2; ++bj) { const f32x4 v0 = acc[ai][bj][m][0], v1 = acc[ai][bj][m][1];
                    u32x4 w; w.x = cvt_pk_bf16(v0[0], v0[1]); w.y = cvt_pk_bf16(v0[2], v0[3]); w.z = cvt_pk_bf16(v1[0], v1[1]); w.w = cvt_pk_bf16(v1[2], v1[3]);
                    __builtin_nontemporal_store(w, (u32x4*)(O + ((size_t)(u.pn * 2 + bj) * NTOK + row) * HD + wc * 32 + 8 * fq)); } }
        if (gain) { asm volatile("s_waitcnt lgkmcnt(0)" ::: "memory"); __builtin_amdgcn_s_barrier(); asm volatile("" ::: "memory"); }
    }
};
__device__ __forceinline__ f32x4 unpack4_bf16(u32x2 w) { return (f32x4){__uint_as_float(w.x << 16), __uint_as_float(w.x & 0xffff0000u), __uint_as_float(w.y << 16), __uint_as_float(w.y & 0xffff0000u)}; }
template <bool BF> struct ErVec { typedef f32x4 type; };
template <> struct ErVec<true> { typedef u32x2 type; };
__device__ __forceinline__ f32x4 er_to4(u32x2 w) { return unpack4_bf16(w); }
__device__ __forceinline__ f32x4 er_to4(f32x4 v) { return v; }
template <bool BASE_BF16, bool OUT_BF16>
struct EpiResid {
    static constexpr bool PERM = false, AFTER_DRAIN = false;
    const void* base; void* out; const float* gate; float scale;
    __device__ __forceinline__ void operator()(f32x4 (&acc)[2][2][4][2], const Unit& u, int wr, int wc, int fr, int fq) const {
        const int row0 = u.pm * BM + wr * 64 + fr, col0 = u.pn * BM + wc * 32 + 4 * fq;
        const float* gp = gate + (size_t)(u.pm >> 4) * NMOD + col0;
        f32x4 gv[2][2];
#pragma unroll
        for (int bj = 0; bj < 2; ++bj)
#pragma unroll
            for (int n = 0; n < 2; ++n) gv[bj][n] = *(const f32x4*)(gp + bj * HALF + n * 16) * scale;
#define ER_OFF(ai, mh, m2, bj, n) ((size_t)(row0 + (ai) * HALF + ((mh) * 2 + (m2)) * 16) * DM + col0 + (bj) * HALF + (n) * 16)
#define ER_LOAD(BS, ai, mh) do { _Pragma("unroll") for (int m2 = 0; m2 < 2; ++m2) _Pragma("unroll") for (int bj = 0; bj < 2; ++bj) _Pragma("unroll") for (int n = 0; n < 2; ++n)       \
            BS[m2][bj][n] = *(const BT*)((const char*)base + ER_OFF(ai, mh, m2, bj, n) * (BASE_BF16 ? 2 : 4)); } while (0)
#define ER_PROC(BS, ai, mh) do { _Pragma("unroll") for (int m2 = 0; m2 < 2; ++m2) _Pragma("unroll") for (int bj = 0; bj < 2; ++bj) _Pragma("unroll") for (int n = 0; n < 2; ++n) {     \
            const size_t off = ER_OFF(ai, mh, m2, bj, n); const f32x4 r = er_to4(BS[m2][bj][n]) + gv[bj][n] * acc[ai][bj][(mh) * 2 + m2][n];                                          \
            if constexpr (OUT_BF16) { u32x2 w; w.x = cvt_pk_bf16(r[0], r[1]); w.y = cvt_pk_bf16(r[2], r[3]); *(u32x2*)((bf16_t*)out + off) = w; } else __builtin_nontemporal_store(r, (f32x4*)((float*)out + off)); } \
            asm volatile("" ::: "memory"); } while (0)
        using BT = typename ErVec<BASE_BF16>::type;
        BT bA[2][2][2];
        if constexpr (BASE_BF16) {
            BT bB[2][2][2], bC[2][2][2];
            ER_LOAD(bA, 0, 0); ER_LOAD(bB, 0, 1); ER_LOAD(bC, 1, 0); asm volatile("" ::: "memory");
            ER_PROC(bA, 0, 0); ER_LOAD(bA, 1, 1); asm volatile("" ::: "memory");
            ER_PROC(bB, 0, 1); ER_PROC(bC, 1, 0); ER_PROC(bA, 1, 1);
        } else {
            ER_LOAD(bA, 0, 0); ER_PROC(bA, 0, 0); ER_LOAD(bA, 0, 1); ER_PROC(bA, 0, 1);
            ER_LOAD(bA, 1, 0); ER_PROC(bA, 1, 0); ER_LOAD(bA, 1, 1); ER_PROC(bA, 1, 1);
        }
#undef ER_OFF
#undef ER_LOAD
#undef ER_PROC
    }
};
struct EpiF32 {
    static constexpr bool PERM = false, AFTER_DRAIN = false;
    float* C; int ldc;
    __device__ __forceinline__ void operator()(f32x4 (&acc)[2][2][4][2], const Unit& u, int wr, int wc, int fr, int fq) const {
        const int row0 = u.pm * BM + wr * 64 + fr, col0 = u.pn * BM + wc * 32 + 4 * fq;
#pragma unroll
        for (int ai = 0; ai < 2; ++ai)
#pragma unroll
            for (int m = 0; m < 4; ++m) { float* rowp = C + (size_t)(row0 + ai * HALF + m * 16) * ldc + col0;
#pragma unroll
                for (int bj = 0; bj < 2; ++bj)
#pragma unroll
                    for (int n = 0; n < 2; ++n) *(f32x4*)(rowp + bj * HALF + n * 16) = acc[ai][bj][m][n]; }
    }
};
struct EpiScoreT {
    static constexpr bool PERM = false, AFTER_DRAIN = false;
    float* C;
    __device__ __forceinline__ void operator()(f32x4 (&acc)[2][2][4][2], const Unit& u, int wr, int wc, int fr, int fq) const {
#pragma unroll
        for (int ai = 0; ai < 2; ++ai)
#pragma unroll
            for (int bj = 0; bj < 2; ++bj) { float* base = C + ((size_t)((u.pn * 2 + bj) * 256 + (u.pm * 4 + ai * 2 + wr)) * 128 + wc * 32 + 4 * fq) * 64 + fr;
#pragma unroll
                for (int m = 0; m < 4; ++m)
#pragma unroll
                    for (int n = 0; n < 2; ++n)
#pragma unroll
                        for (int i = 0; i < 4; ++i) base[(n * 16 + i) * 64 + m * 16] = acc[ai][bj][m][n][i]; }
    }
};
__host__ __device__ __forceinline__ size_t gd_off(int row, int e) {
    const int pm = row >> 8, r = row & 255, ai = r >> 7, wr = (r >> 6) & 1, m = (r >> 4) & 3, fr = r & 15;
    const int pn = e >> 8, ec = e & 255, bj = ec >> 7, wc = (ec >> 5) & 3, fqh = (ec >> 4) & 1, b16 = ec & 15;
    return ((((((size_t)(pm * 64 + pn) * 2 + ai) * 4 + m) * 2 + bj) * 8 + (wr * 4 + wc)) * 16 + fr) * 32 + fqh * 16 + b16;
}
struct EpiSlot {
    static constexpr bool PERM = true, AFTER_DRAIN = false;
    const unsigned char* G; int ldc; float ascale; float* pre;
    __device__ __forceinline__ void operator()(f32x4 (&acc)[2][2][4][2], const Unit& u, int wr, int wc, int fr, int fq) const {
        const int row0 = u.pm * BM + wr * 64 + fr;
        const unsigned char* base = G + ((size_t)(u.pm * 64 + u.pn) * 65536) + (size_t)(wr * 4 + wc) * 512 + fr * 32 + fq * 8;
        u32x2 gw[2][4][2];
#pragma unroll
        for (int ai = 0; ai < 2; ++ai)
#pragma unroll
            for (int m = 0; m < 4; ++m)
#pragma unroll
                for (int bj = 0; bj < 2; ++bj) gw[ai][m][bj] = *(const u32x2*)(base + ((ai * 4 + m) * 2 + bj) * 4096);
#pragma unroll
        for (int ai = 0; ai < 2; ++ai)
#pragma unroll
            for (int m = 0; m < 4; ++m)
#pragma unroll
                for (int bj = 0; bj < 2; ++bj) {
                    const u32x2 g = gw[ai][m][bj];
                    if ((g.x | g.y) != 0u) {
                        float* prow = pre + (size_t)(row0 + ai * HALF + m * 16) * 128 - 1;
#pragma unroll
                        for (int e = 0; e < 8; ++e) { const unsigned sl = ((e < 4 ? g.x : g.y) >> (8 * (e & 3))) & 0xffu;
                            if (sl) prow[sl] = acc[ai][bj][m][e >> 2][e & 3] * ascale; }
                    }
                }
    }
};

template <class Epi, class Sched, bool ALIGN_EPI = false, bool SP2 = false, int ES = 2, bool ATILE = false>
__device__ __forceinline__ void gemm_phase(LAS unsigned char* lds, const Gemm g, const Sched& S, const Epi& E, int wv_) {
    int tid_o = TIDX;
    const int tid = tid_o, wid = wv_, lane = tid & 63, wr = wid >> 2, wc = wid & 3, fr = lane & 15, fq = lane >> 4;
    const int K = g.K * (ES == 2 ? 2 : 1) / 2  , nt = K / BK;
    unsigned voffA[2], voffB[2];
#pragma unroll
    for (int i = 0; i < 2; ++i) { int R, C; stage_rc(tid * 16 + i * 8192, R, C); const int Rb = Epi::PERM ? ((R & ~31) + perm32(R & 31)) : R;
        voffA[i] = ATILE ? (unsigned)(((R >> 4) & 3) * 8192 + (R >> 6) * 2048 + (R & 15) * 32 + ((C >> 3) >> 1) * 512 + ((C >> 3) & 1) * 16) : (unsigned)(R * K + C) * 2u;
        voffB[i] = (unsigned)(Rb * K + C) * 2u; }
    const size_t kstep = (size_t)(BK * 2);
    const size_t hstep = (size_t)HALF * K * 2;
    const size_t tstep = 2 * hstep;
    const size_t hstepA = ATILE ? (size_t)32768 : hstep;
#define PG8_KA(t_) (ATILE ? ((size_t)((t_) >> 1) * 65536 + (size_t)((t_) & 1) * 4096) : (size_t)(t_) * kstep)
    const unsigned ldsw = (unsigned)wid * 1024u;
    const int aoff = lds_byte(wr * 64 + fr, fq * 8), boff = lds_byte(wc * 32 + fr, fq * 8);
#define PG8_SA(b, h) (((b) * 2 + (h)) * HTB)
#define PG8_SB(b, h) ((4 + (b) * 2 + (h)) * HTB)
#define PG8_STAGE(bufoff, gbase, voff) do { _Pragma("unroll") for (int _i = 0; _i < 2; ++_i) \
        __builtin_amdgcn_global_load_lds((const unsigned*)((const char*)(gbase) + (voff)[_i]), (LAS unsigned*)(lds + (bufoff) + ldsw + _i * 8192), 16, 0, 0); } while (0)
#define PG8_RD(off) (*(const LAS bf16x8*)(lds + (off)))
#define PG8_CAT2(x, y) __builtin_shufflevector(__builtin_bit_cast(i32x4, (x)), __builtin_bit_cast(i32x4, (y)), 0, 1, 2, 3, 4, 5, 6, 7)
#define PG8_RD6(off) __builtin_shufflevector(__builtin_shufflevector(*(const LAS i32x4*)(lds + (off)), *(const LAS i32x4*)(lds + (off)), 0, 1, 2, 3, -1, -1), \
                                             __builtin_shufflevector(*(const LAS i32x2*)(lds + (off) + 1024), *(const LAS i32x2*)(lds + (off) + 1024), 0, 1, -1, -1, -1, -1), 0, 1, 2, 3, 6, 7)
#define PG8_LDA(dst, b, h) do { _Pragma("unroll") for (int m = 0; m < 4; ++m) { const int o_ = PG8_SA(b, h) + aoff + m * 2048; \
        if constexpr (ES == 2) { dst[m][0] = PG8_RD(o_); dst[m][1] = PG8_RD(o_ + 1024); } else if constexpr (ES == 1) dst##8[m] = PG8_CAT2(PG8_RD(o_), PG8_RD(o_ + 1024)); else dst##6[m] = PG8_RD6(o_); } } while (0)
#define PG8_LDB(dst, b, h) do { _Pragma("unroll") for (int n = 0; n < 2; ++n) { const int o_ = PG8_SB(b, h) + boff + n * 2048; \
        if constexpr (ES == 2) { dst[n][0] = PG8_RD(o_); dst[n][1] = PG8_RD(o_ + 1024); } else if constexpr (ES == 1) dst##8[n] = PG8_CAT2(PG8_RD(o_), PG8_RD(o_ + 1024)); else dst##6[n] = PG8_RD6(o_); } } while (0)
#define PG8_MMA(ai, bj, At, Bt) do { __builtin_amdgcn_s_setprio(1); _Pragma("unroll") for (int m = 0; m < 4; ++m) _Pragma("unroll") for (int n = 0; n < 2; ++n) { \
        if constexpr (ES == 2) { _Pragma("unroll") for (int k = 0; k < 2; ++k) acc[ai][bj][m][n] = __builtin_amdgcn_mfma_f32_16x16x32_bf16(Bt[n][k], At[m][k], acc[ai][bj][m][n], 0, 0, 0); } \
        else if constexpr (ES == 1) asm volatile("v_mfma_f32_16x16x128_f8f6f4 %0, %1, %2, %0" : "+v"(acc[ai][bj][m][n]) : "v"(Bt##8[n]), "v"(At##8[m])); \
        else asm volatile("v_mfma_f32_16x16x128_f8f6f4 %0, %1, %2, %0 cbsz:2 blgp:2" : "+v"(acc[ai][bj][m][n]) : "v"(Bt##6[n]), "v"(At##6[m])); } \
        __builtin_amdgcn_s_setprio(0); } while (0)
#define PG8_WAIT_V(n) asm volatile("s_waitcnt vmcnt(" #n ")" ::: "memory")
#define PG8_WAIT_L(n) asm volatile("s_waitcnt lgkmcnt(" #n ")" ::: "memory")
#define PG8_BAR __builtin_amdgcn_s_barrier()
#define PG8_SCHED __builtin_amdgcn_sched_barrier(0)
    Unit cur, nxt; int ui = 0;
    if (!S.next(0, cur)) return;
    f32x4 acc[2][2][4][2];
#pragma unroll
    for (int a = 0; a < 2; ++a)
#pragma unroll
        for (int b = 0; b < 2; ++b)
#pragma unroll
            for (int m = 0; m < 4; ++m)
#pragma unroll
                for (int n = 0; n < 2; ++n) acc[a][b][m][n] = (f32x4){0.f, 0.f, 0.f, 0.f};
    bf16x8 At[4][2], B0[2][2], B1[2][2]; i32x8 At8[4], B08[2], B18[2]; i32x6 At6[4], B06[2], B16[2];
    const char* cA = (const char*)g.A + (size_t)cur.pm * tstep; const char* cB = (const char*)g.Bt + (size_t)cur.pn * tstep;
    S.a_ready(cur);
    if constexpr (SP2) {
        PG8_STAGE(PG8_SB(0, 0), cB, voffB); PG8_STAGE(PG8_SB(0, 1), cB + hstep, voffB); PG8_STAGE(PG8_SA(0, 0), cA, voffA); PG8_STAGE(PG8_SA(0, 1), cA + hstepA, voffA);
        if (wr == 1) PG8_BAR;
        PG8_WAIT_V(2); PG8_BAR;
        PG8_STAGE(PG8_SB(1, 0), cB + kstep, voffB); PG8_STAGE(PG8_SA(1, 0), cA + PG8_KA(1), voffA); PG8_STAGE(PG8_SB(1, 1), cB + hstep + kstep, voffB);
        PG8_WAIT_V(6); PG8_BAR;
    } else {
        PG8_STAGE(PG8_SB(0, 0), cB, voffB); PG8_STAGE(PG8_SA(0, 0), cA, voffA); PG8_STAGE(PG8_SB(0, 1), cB + hstep, voffB); PG8_STAGE(PG8_SA(0, 1), cA + hstepA, voffA);
        if (wr == 1) PG8_BAR;
        PG8_WAIT_V(4); PG8_BAR;
        PG8_STAGE(PG8_SB(1, 0), cB + kstep, voffB); PG8_STAGE(PG8_SA(1, 0), cA + PG8_KA(1), voffA); PG8_STAGE(PG8_SB(1, 1), cB + hstep + kstep, voffB);
        PG8_WAIT_V(6); PG8_BAR;
    }
    for (;;) {
        const bool has_next = S.next(ui + 1, nxt);
        const char* nA = has_next ? (const char*)g.A + (size_t)nxt.pm * tstep : cA; const char* nB = has_next ? (const char*)g.Bt + (size_t)nxt.pn * tstep : cB;
        for (int t = 0; t < nt; t += 2) {
            const bool last = (t == nt - 2);
            const char* a1 = cA + PG8_KA(t + 1);
            const char* a2 = last ? nA : cA + PG8_KA(t + 2); const char* b2 = last ? nB : cB + (size_t)(t + 2) * kstep;
            const char* a3 = a2 + PG8_KA(1); const char* b3 = b2 + kstep;
            if (last && has_next) S.a_ready(nxt);
            if constexpr (SP2) {
            PG8_LDB(B0, 0, 0); PG8_LDB(B1, 0, 1); PG8_SCHED; PG8_LDA(At, 0, 0); PG8_STAGE(PG8_SA(1, 1), a1 + hstepA, voffA);
            PG8_WAIT_V(8); PG8_WAIT_L(0); PG8_BAR; PG8_MMA(0, 0, At, B0); PG8_MMA(0, 1, At, B1); PG8_BAR; PG8_SCHED;
            PG8_LDA(At, 0, 1); PG8_STAGE(PG8_SB(0, 0), b2, voffB); PG8_STAGE(PG8_SB(0, 1), b2 + hstep, voffB); PG8_STAGE(PG8_SA(0, 0), a2, voffA);
            PG8_WAIT_V(8); PG8_WAIT_L(0); PG8_BAR; PG8_MMA(1, 0, At, B0); PG8_MMA(1, 1, At, B1); PG8_BAR; PG8_SCHED;
            PG8_LDB(B0, 1, 0); PG8_LDB(B1, 1, 1); PG8_SCHED; PG8_LDA(At, 1, 0); PG8_STAGE(PG8_SA(0, 1), a2 + hstepA, voffA);
            PG8_WAIT_V(8); PG8_WAIT_L(0); PG8_BAR; PG8_MMA(0, 0, At, B0); PG8_MMA(0, 1, At, B1); PG8_BAR; PG8_SCHED;
            PG8_LDA(At, 1, 1); PG8_STAGE(PG8_SB(1, 0), b3, voffB); PG8_STAGE(PG8_SB(1, 1), b3 + hstep, voffB); PG8_STAGE(PG8_SA(1, 0), a3, voffA);
            PG8_WAIT_V(8); PG8_WAIT_L(0); PG8_BAR; PG8_MMA(1, 0, At, B0); PG8_MMA(1, 1, At, B1); PG8_BAR; PG8_SCHED;
            } else {
            PG8_LDB(B0, 0, 0); PG8_SCHED; PG8_LDA(At, 0, 0); PG8_STAGE(PG8_SA(1, 1), a1 + hstepA, voffA);
            PG8_WAIT_L(8); PG8_BAR; PG8_WAIT_L(0); PG8_MMA(0, 0, At, B0); PG8_BAR; PG8_SCHED;
            PG8_LDB(B1, 0, 1); PG8_STAGE(PG8_SB(0, 0), b2, voffB);
            PG8_BAR; PG8_WAIT_L(0); PG8_MMA(0, 1, At, B1); PG8_BAR;
            PG8_LDA(At, 0, 1); PG8_STAGE(PG8_SA(0, 0), a2, voffA);
            PG8_BAR; PG8_WAIT_L(0); PG8_MMA(1, 0, At, B0); PG8_BAR; PG8_SCHED;
            PG8_STAGE(PG8_SB(0, 1), b2 + hstep, voffB);
            PG8_WAIT_V(6); PG8_BAR; PG8_MMA(1, 1, At, B1); PG8_BAR;
            PG8_LDB(B0, 1, 0); PG8_SCHED; PG8_LDA(At, 1, 0); PG8_STAGE(PG8_SA(0, 1), a2 + hstepA, voffA);
            PG8_WAIT_L(8); PG8_BAR; PG8_WAIT_L(0); PG8_MMA(0, 0, At, B0); PG8_BAR; PG8_SCHED;
            PG8_LDB(B1, 1, 1); PG8_STAGE(PG8_SB(1, 0), b3, voffB);
            PG8_BAR; PG8_WAIT_L(0); PG8_MMA(0, 1, At, B1); PG8_BAR;
            PG8_LDA(At, 1, 1); PG8_STAGE(PG8_SA(1, 0), a3, voffA);
            PG8_BAR; PG8_WAIT_L(0); PG8_MMA(1, 0, At, B0); PG8_BAR; PG8_SCHED;
            PG8_STAGE(PG8_SB(1, 1), b3 + hstep, voffB);
            PG8_WAIT_V(6); PG8_BAR; PG8_MMA(1, 1, At, B1); PG8_BAR;
            }
        }
        if constexpr (ES != 2) asm volatile("s_nop 15\n\ts_nop 15" ::: "memory");
        if constexpr (ALIGN_EPI) { if (wr == 0) PG8_BAR; }
        if constexpr (!Epi::AFTER_DRAIN) { E(acc, cur, wr, wc, fr, fq); S.done(cur); }
        if (!has_next) break;
#pragma unroll
        for (int a = 0; a < 2; ++a)
#pragma unroll
            for (int b = 0; b < 2; ++b)
#pragma unroll
                for (int m = 0; m < 4; ++m)
#pragma unroll
                    for (int n = 0; n < 2; ++n) acc[a][b][m][n] = (f32x4){0.f, 0.f, 0.f, 0.f};
        cur = nxt; cA = nA; cB = nB; ++ui;
        if constexpr (ALIGN_EPI) { if (wr == 1) PG8_BAR; }
    }
    PG8_WAIT_V(0);
    if constexpr (!ALIGN_EPI) { if (wr == 0) PG8_BAR; }
    PG8_BAR;
#undef PG8_SA
#undef PG8_KA
#undef PG8_SB
#undef PG8_STAGE
#undef PG8_LDA
#undef PG8_LDB
#undef PG8_MMA
#undef PG8_CAT2
#undef PG8_RD
#undef PG8_RD6
#undef PG8_WAIT_V
#undef PG8_WAIT_L
#undef PG8_BAR
#undef PG8_SCHED
}
}

__device__ __forceinline__ float wave_sum(float v) {
#pragma unroll
    for (int o = 32; o >= 1; o >>= 1) v += __shfl_xor(v, o);
    return v;
}
__device__ __forceinline__ u32x2 pack4(f32x4 v) { u32x2 w; w.x = cvt_pk_bf16(v[0], v[1]); w.y = cvt_pk_bf16(v[2], v[3]); return w; }
__device__ __forceinline__ u32x4 pack8(f32x4 a, f32x4 b) { u32x4 w; w.x = cvt_pk_bf16(a[0], a[1]); w.y = cvt_pk_bf16(a[2], a[3]); w.z = cvt_pk_bf16(b[0], b[1]); w.w = cvt_pk_bf16(b[2], b[3]); return w; }

__device__ __forceinline__ void p0_mod(const float* c, const float* w_ada, const float* b_ada, float* mod, LAS unsigned char* lds, int bid, int nb, int wv_) {
    const int tid = TIDX;
    LAS float* s = (LAS float*)lds;
    LAS float* red = (LAS float*)(lds + 65536);
    for (int i = tid; i < NBATCH * DM; i += NTHREADS) { const float v = c[i]; s[i] = v / (1.0f + __expf(-v)); }
    __syncthreads();
    const int cq = tid % 24, kl = tid / 24;
    for (int chunk = bid; chunk < NMOD / 96; chunk += nb) {
        float acc[4][4];
#pragma unroll
        for (int b = 0; b < 4; ++b)
#pragma unroll
            for (int j = 0; j < 4; ++j) acc[b][j] = 0.f;
        if (tid < 504) {
            const float* wp = w_ada + (size_t)chunk * 96 + cq * 4;
#pragma unroll 8
            for (int k = kl; k < DM; k += 21) {
                const f32x4 w = *(const f32x4*)(wp + (size_t)k * NMOD);
#pragma unroll
                for (int b = 0; b < 4; ++b) { const float sb = s[b * DM + k];
#pragma unroll
                    for (int j = 0; j < 4; ++j) acc[b][j] += sb * w[j]; }
            }
#pragma unroll
            for (int b = 0; b < 4; ++b)
#pragma unroll
                for (int j = 0; j < 4; ++j) red[(kl * 4 + b) * 96 + cq * 4 + j] = acc[b][j];
        }
        __syncthreads();
        if (tid < 384) { const int b = tid / 96, cc = tid % 96; float t = 0.f;
            for (int k = 0; k < 21; ++k) t += red[(k * 4 + b) * 96 + cc];
            mod[(size_t)b * NMOD + chunk * 96 + cc] = t + b_ada[chunk * 96 + cc]; }
        __syncthreads();
    }
}
__device__ __forceinline__ void p0_transpose(const float* src, size_t ldS, unsigned char* dst, size_t ldD, int R, int C, float scale, LAS unsigned char* lds, int bid, int nb, int wv_) {
    const int tid = TIDX; LAS float* tile = (LAS float*)lds;
    const int ntc = C / 64, ntiles = (R / 256) * ntc;
    f32x4 v[8];
#define P0T_LOAD(t_) do { const int tr_ = (t_) / ntc, tc_ = (t_) % ntc; _Pragma("unroll") for (int i = 0; i < 8; ++i) { const int r = (tid >> 4) + 32 * i, c4 = (tid & 15) * 4; \
        v[i] = *(const f32x4*)(src + (size_t)(tr_ * 256 + r) * ldS + tc_ * 64 + c4); } } while (0)
    if (bid < ntiles) P0T_LOAD(bid);
    for (int t = bid; t < ntiles; t += nb) {
        const int tr = t / ntc, tc = t % ntc;
#pragma unroll
        for (int i = 0; i < 8; ++i) { const int r = (tid >> 4) + 32 * i, c4 = (tid & 15) * 4;
#pragma unroll
            for (int j = 0; j < 4; ++j) tile[r * 65 + c4 + j] = v[i][j]; }
        __syncthreads();
        if (t + nb < ntiles) P0T_LOAD(t + nb);
        { const int cc = tid >> 3, r0 = (tid & 7) * 32; u32x2 w[4];
#pragma unroll
            for (int q = 0; q < 4; ++q) { f32x4 a, b;
#pragma unroll
                for (int j = 0; j < 4; ++j) { a[j] = tile[(r0 + q * 8 + j) * 65 + cc] * scale; b[j] = tile[(r0 + q * 8 + 4 + j) * 65 + cc] * scale; }
                w[q] = pack8_fp8(a, b); }
            unsigned char* dp = dst + (size_t)(tc * 64 + cc) * ldD + tr * 256 + r0;
            *(u32x4*)dp = (u32x4){w[0].x, w[0].y, w[1].x, w[1].y}; *(u32x4*)(dp + 16) = (u32x4){w[2].x, w[2].y, w[3].x, w[3].y}; }
        __syncthreads();
    }
#undef P0T_LOAD
}
__device__ __forceinline__ void p0_wc(const float* w_pq, const float* sk1, const float* sk2, bf16_t* wct, LAS unsigned char* lds, int bid, int nb, int wv_) {
    const int tid = TIDX, kk = tid & 63, kg = tid >> 6;
    LAS float* Ws = (LAS float*)lds;
    LAS float* Ss = (LAS float*)(lds + 64 * 132 * 4);
    for (int task = bid; task < 16 * 64; task += nb) {
        const int hh = task >> 6, kc = task & 63; const float* sk = (hh & 1) ? sk2 : sk1;
#pragma unroll
        for (int i = 0; i < 4; ++i) { const int idx = tid + 512 * i, r = idx >> 5, c4 = (idx & 31) * 4;
            *(LAS f32x4*)(Ws + r * 132 + c4) = *(const f32x4*)(w_pq + (size_t)(kc * 64 + r) * (PHEADS * 256) + hh * 128 + c4); }
#pragma unroll
        for (int i = 0; i < 8; ++i) { const int idx = tid + 512 * i, r = idx >> 5, c4 = (idx & 31) * 4;
            *(LAS f32x4*)(Ss + r * 132 + c4) = *(const f32x4*)(sk + (size_t)r * 128 + c4); }
        __syncthreads();
        float acc[4][4];
#pragma unroll
        for (int i = 0; i < 4; ++i)
#pragma unroll
            for (int j = 0; j < 4; ++j) acc[i][j] = 0.f;
        const int tk = tid & 15, tj = tid >> 4;
#pragma unroll 4
        for (int d4 = 0; d4 < 32; ++d4) {
            f32x4 w[4], sv[4];
#pragma unroll
            for (int i = 0; i < 4; ++i) w[i] = *(const LAS f32x4*)(Ws + (tk + 16 * i) * 132 + d4 * 4);
#pragma unroll
            for (int j = 0; j < 4; ++j) sv[j] = *(const LAS f32x4*)(Ss + (4 * tj + j) * 132 + d4 * 4);
#pragma unroll
            for (int i = 0; i < 4; ++i)
#pragma unroll
                for (int j = 0; j < 4; ++j) acc[i][j] += (w[i][0] * sv[j][0] + w[i][1] * sv[j][1]) + (w[i][2] * sv[j][2] + w[i][3] * sv[j][3]);
        }
#pragma unroll
        for (int i = 0; i < 4; ++i)
#pragma unroll
            for (int j = 0; j < 4; ++j) wct[(size_t)(hh * 128 + 4 * tj + j) * DM + kc * 64 + tk + 16 * i] = f2bf(acc[i][j]);
        __syncthreads();
    }
}
__device__ __forceinline__ void p0_prologue(const Args& a, LAS unsigned char* lds, int bid, int nb, int wv_) {
    unsigned char* ws = a.ws; const int tid = TIDX;
    p0_mod(a.in[1], a.in[2], a.in[3], (float*)(ws + WS_MOD), lds, bid, nb, wv_);
    p0_transpose(a.in[5], INC, ws + WS_WINT, DM, DM, NQKV, 64.0f, lds, bid, nb, wv_);
    p0_transpose(a.in[12], DM, ws + WS_WOT, DM, DM, DM, 64.0f, lds, bid, nb, wv_);
    p0_transpose(a.in[18], DM, ws + WS_VT, NEXP, NEXP, DM, 1.0f, lds, bid, nb, wv_);
    p0_wc(a.in[14], a.in[15], a.in[16], (bf16_t*)(ws + WS_WCT), lds, bid, nb, wv_);
    {
        const float* u = a.in[17]; unsigned char* ub = ws + WS_UB; const size_t n8 = (size_t)NEXP * DM / 8;
        const size_t st = (size_t)nb * NTHREADS; size_t i = (size_t)bid * NTHREADS + tid;
        for (; i + 7 * st < n8; i += 8 * st) {
            f32x4 x[16];
#pragma unroll
            for (int q = 0; q < 8; ++q) { x[2 * q] = *(const f32x4*)(u + (i + q * st) * 8); x[2 * q + 1] = *(const f32x4*)(u + (i + q * st) * 8 + 4); }
#pragma unroll
            for (int q = 0; q < 8; ++q) *(u32x2*)(ub + (i + q * st) * 8) = pack8_fp8(x[2 * q] * 64.0f, x[2 * q + 1] * 64.0f); }
        for (; i < n8; i += st) {
            const f32x4 x0 = *(const f32x4*)(u + i * 8), x1 = *(const f32x4*)(u + i * 8 + 4); *(u32x2*)(ub + i * 8) = pack8_fp8(x0 * 64.0f, x1 * 64.0f); }
    }
    {
        const float* w = a.in[5]; bf16_t* wf = (bf16_t*)(ws + WS_WFZT);
        for (int k = bid * NTHREADS + tid; k < DM; k += nb * NTHREADS) {
#pragma unroll
            for (int q = 0; q < 4; ++q) { const f32x4 v = *(const f32x4*)(w + (size_t)k * INC + NQKV + q * 4);
#pragma unroll
                for (int j = 0; j < 4; ++j) wf[(size_t)(q * 4 + j) * DM + k] = f2bf(v[j]); } }
    }
}

template <bool WITH_FZ, bool WITH_F8, bool WITH_BF16, bool WITH_F6 = false, bool IN_BF16 = false>
__device__ __forceinline__ void norm_phase(const void* xin, const float* g, const float* sh, const float* sc, bf16_t* out, unsigned char* out8,
                                           const bf16_t* wfzt, const float* b_f, float* logf, LAS unsigned char* lds, int bid, int nb, int wv_) {
    const int tid = TIDX, wid = wv_, lane = tid & 63;
    constexpr int ROWB = DM * 2 + 16;
    LAS float* red = (LAS float*)(lds + 16 * ROWB);
    using XT = typename pg8::ErVec<IN_BF16>::type;
#define NR_LOAD(BUF, row_) do { _Pragma("unroll") for (int j = 0; j < 16; ++j)                                                                                       \
        BUF[j] = *(const XT*)((const char*)xin + ((size_t)(row_) * DM + j * 256 + lane * 4) * (IN_BF16 ? 2 : 4)); } while (0)
#define NR_ROW(BUF, rr_) do { const int lr = wid * 2 + (rr_);                                                                                                        \
            float ss = 0.f;                                                                                                                                            \
            _Pragma("unroll") for (int j = 0; j < 16; ++j) { const f32x4 v = pg8::er_to4(BUF[j]); ss += (v[0] * v[0] + v[1] * v[1]) + (v[2] * v[2] + v[3] * v[3]); }      \
            ss = wave_sum(ss);                                                                                                                                         \
            const float rinv = __builtin_amdgcn_rsqf(ss * (1.0f / DM) + NORM_EPS);                                                                                     \
            _Pragma("unroll") for (int j = 0; j < 16; ++j) { const int cidx = j * 256 + lane * 4;                                                                      \
                const f32x4 vj = pg8::er_to4(BUF[j]);                                                                                                                 \
                f32x4 pa_, ph_;                                                                                                                                        \
                if constexpr (PBF) { pa_ = pg8::unpack4_bf16(*(const LAS u32x2*)(pb + cidx * 2)); ph_ = pg8::unpack4_bf16(*(const LAS u32x2*)(pb + 8192 + cidx * 2)); }   \
                else { pa_ = *(const LAS f32x4*)(pb + cidx * 4); ph_ = *(const LAS f32x4*)(pb + 16384 + cidx * 4); }                                                    \
                const f32x4 y = (vj * rinv) * pa_ + ph_; const u32x2 w = pack4(y);                                                                                     \
                if constexpr (WITH_BF16) *(u32x2*)(out + (size_t)(r0 + lr) * DM + cidx) = w;                                                                            \
                if constexpr (WITH_F8) { int w8 = __builtin_amdgcn_cvt_pk_fp8_f32(y[0], y[1], 0, false); w8 = __builtin_amdgcn_cvt_pk_fp8_f32(y[2], y[3], w8, true); *(int*)(out8 + (size_t)(r0 + lr) * DM + cidx) = w8; } \
                if constexpr (WITH_FZ) *(LAS u32x2*)(lds + lr * ROWB + cidx * 2) = w;                                                                                   \
                if constexpr (WITH_F6) *(LAS u32x2*)(lds + lr * ROWB + cidx * 2) = pack4(y * 1.6f); } } while (0)
    constexpr bool PBF = WITH_FZ || WITH_F6;
    LAS unsigned char* pb = lds + (PBF ? 16 * ROWB + 8192 : 0);
    XT rowA[16], rowB[16];
    if (bid < NTOK / 16) NR_LOAD(rowA, bid * 16 + wid * 2);
    for (int it = bid; it < NTOK / 16; it += nb) {
        const int r0 = it * 16, b = r0 / SEQ;
        {
            const int c8 = tid * 8;
            const f32x4 g0 = *(const f32x4*)(g + c8), g1 = *(const f32x4*)(g + c8 + 4), s0 = *(const f32x4*)(sc + (size_t)b * NMOD + c8), s1 = *(const f32x4*)(sc + (size_t)b * NMOD + c8 + 4);
            const f32x4 h0 = *(const f32x4*)(sh + (size_t)b * NMOD + c8), h1 = *(const f32x4*)(sh + (size_t)b * NMOD + c8 + 4);
            NR_LOAD(rowB, r0 + wid * 2 + 1);
            __syncthreads();
            { const f32x4 a0 = g0 * (s0 + 1.0f), a1 = g1 * (s1 + 1.0f);
              if constexpr (PBF) { *(LAS u32x4*)(pb + c8 * 2) = pack8(a0, a1); *(LAS u32x4*)(pb + 8192 + c8 * 2) = pack8(h0, h1); }
              else { *(LAS f32x4*)(pb + c8 * 4) = a0; *(LAS f32x4*)(pb + c8 * 4 + 16) = a1; *(LAS f32x4*)(pb + 16384 + c8 * 4) = h0; *(LAS f32x4*)(pb + 16384 + c8 * 4 + 16) = h1; } }
            __syncthreads();
            NR_ROW(rowA, 0);
            if (it + nb < NTOK / 16) NR_LOAD(rowA, (it + nb) * 16 + wid * 2);
            NR_ROW(rowB, 1);
        }
        if constexpr (WITH_F6) {
            __syncthreads();
#pragma unroll
            for (int i = 0; i < 4; ++i) { const int G = tid + NTHREADS * i, row = G >> 7, grp = G & 127;
                u32x16 w;
#pragma unroll
                for (int q = 0; q < 4; ++q) { const u32x4 t = *(const LAS u32x4*)(lds + row * ROWB + grp * 64 + q * 16); w[4 * q] = t[0]; w[4 * q + 1] = t[1]; w[4 * q + 2] = t[2]; w[4 * q + 3] = t[3]; }
                const i32x6 pk = __builtin_amdgcn_cvt_scalef32_pk32_fp6_bf16(__builtin_bit_cast(bf16x32, w), 1.0f);
                store_fp6_slot(out8 + (size_t)(r0 + row) * DM + (grp >> 2) * 128, grp & 3, pk); }
            __syncthreads();
        }
        if constexpr (WITH_FZ) {
            f32x4 acc = {0.f, 0.f, 0.f, 0.f}; const int fr = lane & 15, fq = lane >> 4;
            bf16x8 bfr[16];
#pragma unroll
            for (int ks = 0; ks < 16; ++ks) bfr[ks] = *(const bf16x8*)(wfzt + (size_t)fr * DM + wid * 512 + ks * 32 + fq * 8);
            __syncthreads();
#pragma unroll
            for (int ks = 0; ks < 16; ++ks) { const int k0 = wid * 512 + ks * 32 + fq * 8;
                const bf16x8 af = *(const LAS bf16x8*)(lds + fr * ROWB + k0 * 2);
                acc = __builtin_amdgcn_mfma_f32_16x16x32_bf16(af, bfr[ks], acc, 0, 0, 0); }
#pragma unroll
            for (int j = 0; j < 4; ++j) red[wid * 256 + (fq * 4 + j) * 16 + fr] = acc[j];
            __syncthreads();
            if (tid < 256) { float z = 0.f;
                const int row = tid & 15, n = tid >> 4;
#pragma unroll
                for (int w = 0; w < 8; ++w) z += red[w * 256 + row * 16 + n];
                z += b_f[n];
                const float lf = fminf(z, 0.f) - log1pf(__expf(-fabsf(z)));
                const int tok = r0 + row; logf[((size_t)(tok / SEQ) * NHB + n) * SEQ + (tok % SEQ)] = lf; }
            __syncthreads();
        }
    }
}

#undef NR_LOAD
#undef NR_ROW
__device__ __forceinline__ void cumsum_phase(const float* logf, float* nbias, LAS unsigned char* aux, int bid, int nb, int wv_) {
    const int tid = TIDX, wid = wv_, lane = tid & 63; LAS float* wt = (LAS float*)aux;
    for (int seq = bid; seq < NBATCH * NHB; seq += nb) {
        const float* p = logf + (size_t)seq * SEQ + tid * 8; const f32x4 a = *(const f32x4*)p, b = *(const f32x4*)(p + 4);
        float v[8] = {a[0], a[1], a[2], a[3], b[0], b[1], b[2], b[3]};
#pragma unroll
        for (int j = 1; j < 8; ++j) v[j] += v[j - 1];
        float incl = v[7];
#pragma unroll
        for (int o = 1; o < 64; o <<= 1) { const float t = __shfl_up(incl, o); if (lane >= o) incl += t; }
        if (lane == 63) wt[wid] = incl;
        __syncthreads();
        float off = incl - v[7];
        for (int w = 0; w < wid; ++w) off += wt[w];
        f32x4 o0, o1;
#pragma unroll
        for (int j = 0; j < 4; ++j) { o0[j] = -(v[j] + off) * 11.313708498984761f; o1[j] = -(v[4 + j] + off) * 11.313708498984761f; }
        float* q = nbias + (size_t)seq * SEQ + tid * 8; *(f32x4*)q = o0; *(f32x4*)(q + 4) = o1;
        __syncthreads();
    }
}

namespace att {
constexpr float SCALE = 0.08838834764831845f, C2 = 1.4426950408889634f * SCALE, RSCALE = 11.313708498984761f;
constexpr int TAB_N = 2049;
__device__ __forceinline__ int v_rd_base(int lane) { return ((lane & 3) << 3) | (((lane >> 2) & 3) << 6) | (((lane >> 4) & 1) << 5) | (((lane >> 5) & 1) << 8); }
__device__ __forceinline__ int crow(int r, int hi) { return (r & 3) + 8 * (r >> 2) + 4 * hi; }
__device__ __forceinline__ int t5_bucket(int dist) {
    if (dist < 16) return dist;
    const float v = logf((float)dist * (1.0f / 16.0f)) / 4.852030263919617f * 16.0f;
    int large = 16 + (int)v; return large < 31 ? large : 31;
}

}

#ifndef ATT_PROBE
#define ATT_PROBE 0
#endif
#ifndef FOXDBG
#define FOXDBG 1
#endif
namespace att2 {
using att::crow; using att::t5_bucket; using att::v_rd_base;
constexpr float SCALE = att::SCALE, C2 = att::C2, RSCALE = att::RSCALE; constexpr int TAB_N = att::TAB_N;
#define GLDS16(gptr, ldsptr) __builtin_amdgcn_global_load_lds((const unsigned*)(gptr), (LAS unsigned*)(ldsptr), 16, 0, 0)
#define TABIDX(d) ((int)((d) >> 4) + (int)((d) & 15) * 129)
#define VMW(n) asm volatile("s_waitcnt vmcnt(" #n ")" ::: "memory")
#define BAR_LDS() do { asm volatile("s_waitcnt lgkmcnt(0)" ::: "memory"); __builtin_amdgcn_s_barrier(); asm volatile("" ::: "memory"); } while (0)

template <int NP>
__device__ __forceinline__ void softmax_step(f32x16 (&p)[NP], float& m, float& l, f32x16 (&o)[4], bf16x8 (&pa)[2 * NP], LAS float* xch, int r32, int hi) {
    float pmax = p[0][0];
#pragma unroll
    for (int i = 0; i < NP; ++i)
#pragma unroll
        for (int r = 0; r < 16; ++r) pmax = fmaxf(pmax, p[i][r]);
    { auto rr = __builtin_amdgcn_permlane32_swap(__float_as_uint(pmax), __float_as_uint(pmax), false, false);
      pmax = fmaxf(__uint_as_float(rr[0]), __uint_as_float(rr[1])); }
    const float mn = fmaxf(m, pmax);
    const float alpha = __builtin_amdgcn_exp2f((m - mn) * C2);
    m = mn;
    const float mnL = -mn * C2;
    float ps = 0.f;
#pragma unroll
    for (int i = 0; i < NP; ++i)
#pragma unroll
        for (int r = 0; r < 16; ++r) { p[i][r] = __builtin_amdgcn_exp2f(fmaf(p[i][r], C2, mnL)); ps += p[i][r]; }
    { auto rr = __builtin_amdgcn_permlane32_swap(__float_as_uint(ps), __float_as_uint(ps), false, false);
      ps = __uint_as_float(rr[0]) + __uint_as_float(rr[1]); }
    l = l * alpha + ps;
    if (__any(alpha < 1.f)) {
        if (hi == 0) xch[r32] = alpha;
        asm volatile("s_waitcnt lgkmcnt(0)" ::: "memory");
#pragma unroll
        for (int g = 0; g < 4; ++g) { const f32x4 av = *(const LAS f32x4*)(xch + 8 * g + 4 * hi);
#pragma unroll
            for (int d0 = 0; d0 < 4; ++d0) { o[d0][4 * g + 0] *= av[0]; o[d0][4 * g + 1] *= av[1]; o[d0][4 * g + 2] *= av[2]; o[d0][4 * g + 3] *= av[3]; } }
        asm volatile("" ::: "memory");
    }
#define PK4(P, B_, OUT) do { unsigned a0 = cvt_pk_bf16(P[B_+0], P[B_+1]), a1 = cvt_pk_bf16(P[B_+2], P[B_+3]);                \
        unsigned b0 = cvt_pk_bf16(P[B_+4], P[B_+5]), b1 = cvt_pk_bf16(P[B_+6], P[B_+7]);                                    \
        auto r0 = __builtin_amdgcn_permlane32_swap(a0, b0, false, false); auto r1 = __builtin_amdgcn_permlane32_swap(a1, b1, false, false); \
        u32x4 w = {r0[0], r1[0], r0[1], r1[1]}; OUT = *reinterpret_cast<bf16x8*>(&w); } while (0)
#pragma unroll
    for (int i = 0; i < NP; ++i) { PK4(p[i], 0, pa[2 * i]); PK4(p[i], 8, pa[2 * i + 1]); }
#undef PK4
}
template <int NKS>
__device__ __forceinline__ void pv_step(f32x16 (&o)[4], const bf16x8 (&pa)[NKS], int vb0) {
#define TRRD(dst, off) asm volatile("ds_read_b64_tr_b16 %0, %1 offset:%2" : "=&v"(dst) : "v"(vb0), "i"(off) : "memory")
#define PV_RD(B_, d0) do { TRRD(lo_[B_][0], (d0) * 512); TRRD(hi_[B_][0], (d0) * 512 + 2048); TRRD(lo_[B_][1], (d0) * 512 + 4096); TRRD(hi_[B_][1], (d0) * 512 + 6144);  \
        if constexpr (NKS == 4) { TRRD(lo_[B_][2], (d0) * 512 + 8192); TRRD(hi_[B_][2], (d0) * 512 + 10240); TRRD(lo_[B_][3], (d0) * 512 + 12288); TRRD(hi_[B_][3], (d0) * 512 + 14336); } } while (0)
#define PV_MM(B_, d0) do { _Pragma("unroll") for (int ks = 0; ks < NKS; ++ks)                                                                            \
            o[d0] = __builtin_amdgcn_mfma_f32_32x32x16_bf16(pa[ks], (bf16x8){lo_[B_][ks][0], lo_[B_][ks][1], lo_[B_][ks][2], lo_[B_][ks][3], hi_[B_][ks][0], hi_[B_][ks][1], hi_[B_][ks][2], hi_[B_][ks][3]}, o[d0], 0, 0, 0); } while (0)
#define PV_WAIT(n) do { if constexpr (NKS == 4) { if ((n) != 0) asm volatile("s_waitcnt lgkmcnt(8)" ::: "memory"); else asm volatile("s_waitcnt lgkmcnt(0)" ::: "memory"); }          \
                        else { if ((n) != 0) asm volatile("s_waitcnt lgkmcnt(4)" ::: "memory"); else asm volatile("s_waitcnt lgkmcnt(0)" ::: "memory"); } __builtin_amdgcn_sched_barrier(0); } while (0)
    s16x4 lo_[2][NKS], hi_[2][NKS];
    PV_RD(0, 0);
    PV_RD(1, 1); PV_WAIT(1); PV_MM(0, 0); __builtin_amdgcn_sched_barrier(0);
    PV_RD(0, 2); PV_WAIT(1); PV_MM(1, 1); __builtin_amdgcn_sched_barrier(0);
    PV_RD(1, 3); PV_WAIT(1); PV_MM(0, 2); __builtin_amdgcn_sched_barrier(0);
    PV_WAIT(0); PV_MM(1, 3);
#undef PV_RD
#undef PV_MM
#undef PV_WAIT
#undef TRRD
}
__device__ __forceinline__ void store_o(const f32x16 (&o)[4], float l, unsigned char* mix, size_t tok0, int tstride, int col0, LAS float* xch, int, int) {
    const int lf_ = lane_fresh(), r32 = lf_ & 31, hi = lf_ >> 5;
    asm volatile("" ::: "memory");
    if (hi == 0) xch[32 + r32] = l;
    asm volatile("s_waitcnt lgkmcnt(0)" ::: "memory");
    const int srca = ((4 * (r32 & 7)) + 32 * hi) << 2, dsel = r32 >> 3;
#pragma unroll
    for (int r = 0; r < 16; ++r) { const int rr = crow(r, hi); const float rl = 16.0f * __builtin_amdgcn_rcpf(xch[32 + rr]);
        unsigned char* rowp = mix + (tok0 + (size_t)tstride * rr) * DM + col0;
        int g[4];
#pragma unroll
        for (int d0 = 0; d0 < 4; ++d0) { const float v = o[d0][r] * rl; const float vn = __int_as_float(__builtin_amdgcn_mov_dpp(__float_as_int(v), 0xB1, 0xF, 0xF, true));
            const int pk = __builtin_amdgcn_cvt_pk_fp8_f32(v, vn, 0, false) & 0xffff; const int pk2 = __builtin_amdgcn_mov_dpp(pk, 0x4E, 0xF, 0xF, true);
            g[d0] = __builtin_amdgcn_ds_bpermute(srca, (int)((unsigned)pk | ((unsigned)pk2 << 16))); }
        const int w = dsel == 0 ? g[0] : dsel == 1 ? g[1] : dsel == 2 ? g[2] : g[3];
        *(unsigned*)(rowp + 4 * r32) = (unsigned)w; }
    asm volatile("" ::: "memory");
}

struct CoopSrc { int krow[2], kcol[2], vrow[2], vcol[2]; };
__device__ __forceinline__ void make_ident(bf16x8 (&qb)[2], int l) {
    asm volatile("" : "+v"(l));
    const int r32 = l & 31, j = r32 & 7, on_hi = ((r32 >> 3) & 1) == (l >> 5);
#pragma unroll
    for (int s2 = 0; s2 < 2; ++s2) { const unsigned val = (on_hi && (r32 >> 4) == s2) ? (0x3F80u << (16 * (j & 1))) : 0u; u32x4 w;
#pragma unroll
        for (int k = 0; k < 4; ++k) w[k] = (k == (j >> 1)) ? val : 0u;
        qb[s2] = *reinterpret_cast<bf16x8*>(&w); }
}
template <int MODE>
__device__ __forceinline__ void qk_tile(f32x16 (&p)[2], const bf16x8 (&qr)[8], int tp, int slot, const LAS float* nbl, const int (&kaddr)[4], int hi,
                                        const LAS unsigned char* gtab = nullptr, int nbase = 0, int lane_id = 0, int s2s = 32) {
    if constexpr (MODE == 0) {
#pragma unroll
        for (int g = 0; g < 4; ++g) { const f32x4 b0 = *(const LAS f32x4*)(nbl + tp + 8 * g + 4 * hi), b1 = *(const LAS f32x4*)(nbl + tp + 32 + 8 * g + 4 * hi);
#pragma unroll
            for (int j = 0; j < 4; ++j) { p[0][4 * g + j] = b0[j]; p[1][4 * g + j] = b1[j]; } }
    } else {
#pragma unroll
        for (int r = 0; r < 16; ++r) { p[0][r] = 0.f; p[1][r] = 0.f; }
        bf16x8 qb[2]; make_ident(qb, lane_id);
#pragma unroll
        for (int i = 0; i < 2; ++i)
#pragma unroll
            for (int s2 = 0; s2 < 2; ++s2) { int n0 = nbase + s2s * s2 - 32 * i; n0 = n0 < 0 ? 0 : (n0 > 257 ? 257 : n0);
                const bf16x8 gf = *(const LAS bf16x8*)(gtab + n0 * 16);
                p[i] = __builtin_amdgcn_mfma_f32_32x32x16_bf16(gf, qb[s2], p[i], 0, 0, 0); }
    }
    { int ka_[4];
#pragma unroll
      for (int dd = 0; dd < 4; ++dd) ka_[dd] = kaddr[dd] + slot * 16384;
      bf16x8 kf0[2], kf1[2];
#define QK_RD(B_, d0) do { if ((d0) < 4) { asm volatile("ds_read_b128 %0, %1" : "=&v"(kf0[B_]) : "v"(ka_[(d0) & 3]) : "memory"); asm volatile("ds_read_b128 %0, %1 offset:8192" : "=&v"(kf1[B_]) : "v"(ka_[(d0) & 3]) : "memory"); } \
                           else { asm volatile("ds_read_b128 %0, %1 offset:128" : "=&v"(kf0[B_]) : "v"(ka_[(d0) & 3]) : "memory"); asm volatile("ds_read_b128 %0, %1 offset:8320" : "=&v"(kf1[B_]) : "v"(ka_[(d0) & 3]) : "memory"); } } while (0)
#define QK_MM(B_, d0, n_) do { asm volatile("s_waitcnt lgkmcnt(" #n_ ")" ::: "memory"); __builtin_amdgcn_sched_barrier(0);                                 \
        p[0] = __builtin_amdgcn_mfma_f32_32x32x16_bf16(kf0[B_], qr[d0], p[0], 0, 0, 0); p[1] = __builtin_amdgcn_mfma_f32_32x32x16_bf16(kf1[B_], qr[d0], p[1], 0, 0, 0); __builtin_amdgcn_sched_barrier(0); } while (0)
      QK_RD(0, 0);
      QK_RD(1, 1); QK_MM(0, 0, 2);
      QK_RD(0, 2); QK_MM(1, 1, 2);
      QK_RD(1, 3); QK_MM(0, 2, 2);
      QK_RD(0, 4); QK_MM(1, 3, 2);
      QK_RD(1, 5); QK_MM(0, 4, 2);
      QK_RD(0, 6); QK_MM(1, 5, 2);
      QK_RD(1, 7); QK_MM(0, 6, 2);
      QK_MM(1, 7, 0);
#undef QK_RD
#undef QK_MM
    }
}
template <int MODE>
__device__ __forceinline__ void sm_tile(f32x16 (&p)[2], bf16x8 (&pa)[4], f32x16 (&o)[4], float& m, float& l, int tp, int qpos, int qlo, unsigned wq, const LAS float* tab, LAS float* xch, int r32, int hi) {
    const float NEG = -__builtin_inff(); const int dq = qpos - tp - 4 * hi;
    if constexpr (MODE == 0) {
        if (tp + 63 > qlo) {
#pragma unroll
            for (int r = 0; r < 16; ++r) { const int c = (r & 3) + 8 * (r >> 2); if (c > dq) p[0][r] = NEG; if (c + 32 > dq) p[1][r] = NEG; }
        }
    } else {
        if (tp < 0) {
#pragma unroll
            for (int r = 0; r < 16; ++r) { const int kp = tp + 4 * hi + (r & 3) + 8 * (r >> 2); if (kp < 0) p[0][r] = NEG; if (kp + 32 < 0) p[1][r] = NEG; }
        }
    }
    softmax_step<2>(p, m, l, o, pa, xch, r32, hi);
}
template <int MODE>
__device__ __forceinline__ void coop_tiles(f32x16 (&o)[4], float& m, float& l, bf16x8 (&qr)[8], const bf16_t* Kp, const bf16_t* Vp, int t_first, int n_t, int dir, int pos0, int qpos, int qlo, unsigned wq,
                                           const LAS float* nbl, const LAS float* tab, LAS unsigned char* kbuf, LAS unsigned char* vbuf, const int (&kaddr)[4], int vb00, const CoopSrc& cs,
                                           LAS float* xch, int wid, int r32, int hi, const LAS unsigned char* gtab = nullptr, int nb0 = 0, int t_lo = 0, int t_hi = 1 << 30, int dbg = 0, float bqw = 3e30f) {
#define ISSUE_T(t_, slot_) do { const int lf_ = lane_fresh();           \
        _Pragma("unroll") for (int i = 0; i < 2; ++i) { const int P_ = (2 * wid + i) * 64 + lf_;                                              \
        const int krow_ = P_ >> 4, kcol_ = ((P_ & 15) ^ (krow_ & 7)) * 8;                                                                     \
        const int sb_ = P_ >> 5, kk_ = (sb_ >> 2) * 8 + ((P_ >> 2) & 7), vrow_ = (kk_ & ~0xC) | ((kk_ & 4) << 1) | ((kk_ & 8) >> 1), vcol_ = (sb_ & 3) * 32 + (P_ & 3) * 8; \
        int kp_ = pos0 + 64 * (t_) + krow_; kp_ = kp_ < 0 ? 0 : (kp_ > SEQ - 1 ? SEQ - 1 : kp_);                                              \
        int vp_ = pos0 + 64 * (t_) + vrow_; vp_ = vp_ < 0 ? 0 : (vp_ > SEQ - 1 ? SEQ - 1 : vp_);                                              \
        GLDS16(Kp + (size_t)kp_ * HD + kcol_, kbuf + (slot_) * 16384 + (2 * wid + i) * 1024);                                                 \
        GLDS16(Vp + (size_t)vp_ * HD + vcol_, vbuf + (slot_) * 16384 + (2 * wid + i) * 1024); } } while (0)
    int t_act = 1 << 30;
    if (MODE == 0) t_act = ((qlo + 31 - pos0) >> 6) + 1;
    const bool late = wid >= 4;
    ISSUE_T(t_first, 0);
    if (n_t > 1) ISSUE_T(t_first + dir, 1);
#pragma unroll
    for (int d0 = 0; d0 < 8; ++d0) asm volatile("" : "+v"(qr[d0]));
#define WSTOP(tp_) do { if (MODE == 0 && dir < 0 && (tp_) > 0) wdone = __all(bqw + nbl[(tp_) - 1] < m - 40.0f / C2); } while (0)
    bool wdone = false;
    bf16x8 pa[4]; f32x16 p[2]; int sl = 0; bool prev_on = false; int tp_prev = 0;
    for (int k = 0, t = t_first; k < n_t; ++k, t += dir, sl = (sl + 1) & 3) {
        if (k + 1 < n_t) VMW(4); else VMW(0);
        BAR_LDS();
        if (k + 2 < n_t) ISSUE_T(t + 2 * dir, (sl + 2) & 3);
        if (prev_on) {
            if (late) { sm_tile<MODE>(p, pa, o, m, l, tp_prev, qpos, qlo, wq, tab, xch, r32, hi); WSTOP(tp_prev); }
            pv_step<4>(o, pa, vb00 + ((sl + 3) & 3) * 16384);
        }
        const bool on = MODE == 0 ? (t < t_act && !wdone) : (t >= t_lo && t <= t_hi);
        if (on) {
            const int tp = pos0 + 64 * t;
            qk_tile<MODE>(p, qr, tp, sl, nbl, kaddr, hi, gtab, nb0 - 64 * t, r32 + 32 * hi);
            if (!late) { sm_tile<MODE>(p, pa, o, m, l, tp, qpos, qlo, wq, tab, xch, r32, hi); WSTOP(tp); }
            tp_prev = tp;
        }
        prev_on = on;
    }
    if (prev_on) {
        if (late) sm_tile<MODE>(p, pa, o, m, l, tp_prev, qpos, qlo, wq, tab, xch, r32, hi);
        pv_step<4>(o, pa, vb00 + ((sl + 3) & 3) * 16384);
    }
#undef ISSUE_T
#undef WSTOP
}
__device__ __forceinline__ void coop_setup(CoopSrc& cs, int (&kaddr)[4], LAS unsigned char* kbuf, int wid, int lane, int r32, int hi) {
#pragma unroll
    for (int dd = 0; dd < 4; ++dd) kaddr[dd] = (int)(uintptr_t)kbuf + r32 * 256 + (((2 * dd + hi) ^ (r32 & 7)) << 4);
#pragma unroll
    for (int i = 0; i < 2; ++i) { const int P = (2 * wid + i) * 64 + lane;
        { const int row = P >> 4, c = (P & 15) ^ (row & 7); cs.krow[i] = row; cs.kcol[i] = c * 8; }
        { const int sb = P >> 5, k7 = (P >> 2) & 7, cc = P & 3, kk = (sb >> 2) * 8 + k7, k = (kk & ~0xC) | ((kk & 4) << 1) | ((kk & 8) >> 1); cs.vrow[i] = k; cs.vcol[i] = (sb & 3) * 32 + cc * 8; } }
}

__device__ __forceinline__ void build_gtab(const float* rel_bias, bf16_t* tab, int bid, int nb, int wv_) {
    for (int i = bid * NTHREADS + wv_ * 64 + lane_fresh(); i < NHA * 3 * 258 * 8; i += nb * NTHREADS) {
        const int h = i / (3 * 258 * 8), r = i % (3 * 258 * 8), j = r & 7, e = r >> 3, br = e / 258, n0 = e % 258 - 128;
        const int nn = n0 + j * (br == 0 ? 1 : (16 >> (2 * br)));
        const float v = (nn >= 0 && nn <= 128) ? rel_bias[t5_bucket(nn << (2 * br)) * NHA + h] * RSCALE : -3e30f;
        tab[i] = f2bf(v); }
}
__device__ __forceinline__ void dilated_part(const bf16_t* qkv, const float* rel_bias, unsigned char* mix, LAS unsigned char* lds, int bid, int nb, int wv_) {
    const int wid = wv_; int r32, hi; { const int lf_ = lane_fresh(); r32 = lf_ & 31; hi = lf_ >> 5; }
    LAS unsigned char* kl = lds + wid * 16384;
    LAS unsigned char* kbuf = lds; LAS unsigned char* vbuf = lds + 65536;
    LAS unsigned char* gtab = lds + 131072;
    LAS float* xch = (LAS float*)(lds + 147456) + wid * 64;
    for (int item = bid; item < NBATCH * NHA * 4; item += nb) {
        const int xj = item & 7, xk = item >> 3;
        for (int j4 = 0; j4 < 4; ++j4) {
        const int bh = (xj * 8 + 2 * j4 + (xk >> 4)) & 63, b = bh >> 4, h = bh & 15;
        __syncthreads();
        { const int tg_ = wid * 64 + lane_fresh();
          for (int i = tg_; i < 3 * 258; i += NTHREADS) *(LAS u32x4*)(gtab + i * 16) = *(const u32x4*)((const unsigned char*)rel_bias + (size_t)h * (3 * 258 * 16) + i * 16); }
        const size_t boff = (size_t)b * SEQ;
        const bf16_t* Qp = qkv + ((size_t)(0 + h) * NTOK + boff) * HD; const bf16_t* Kp = qkv + ((size_t)(16 + h) * NTOK + boff) * HD; const bf16_t* Vp = qkv + ((size_t)(32 + h) * NTOK + boff) * HD;
        {
            const int cg = xk & 15, T0 = 8 * (cg & 1) + 512 * (cg >> 1), t0 = T0 + wid;
            bf16x8 qr[8]; f32x16 o[4]; float m = -1e30f, l = 0.f;
            { int lr_ = lane_fresh();
              const int nq = lr_ & 31, qposA = T0 + 64 * wid + 16 * (nq >> 3) + (nq & 7);
#pragma unroll
              for (int d0 = 0; d0 < 8; ++d0) qr[d0] = *(const bf16x8*)(Qp + (size_t)qposA * HD + d0 * 16 + (lr_ >> 5) * 8); }
#pragma unroll
            for (int d0 = 0; d0 < 4; ++d0)
#pragma unroll
                for (int r = 0; r < 16; ++r) o[d0][r] = 0.f;
            __syncthreads();
            { int lo_ = lane_fresh();
              const int r32o = lo_ & 31, hio = lo_ >> 5; int caddr[4]; CoopSrc cs; coop_setup(cs, caddr, kbuf, wid, lo_, r32o, hio);
              const int vb00 = (int)(uintptr_t)vbuf + v_rd_base(lo_);
              const int pos0 = T0 - 128, ts = pos0 < 0 ? ((-pos0) >> 6) : 0;
              coop_tiles<1>(o, m, l, qr, Kp, Vp, ts, 10 - ts, 1, pos0, 0, 0, 0u, nullptr, nullptr, kbuf, vbuf, caddr, vb00, cs, xch, wid, r32, hi, gtab, 64 * wid + 16 * hio + 256 - r32o, wid, wid + 2); }
            __syncthreads();
            const int qpos = t0 + 16 * r32;
            { int lh_ = lane_fresh();
              const int nh = lh_ & 31, hh_ = lh_ >> 5;
#pragma unroll
              for (int d0 = 0; d0 < 8; ++d0) qr[d0] = *(const bf16x8*)(Qp + (size_t)(t0 + 16 * nh) * HD + d0 * 16 + hh_ * 8);
              { LAS float* ob = (LAS float*)lds + 32 * wid * 128 + nh;
#pragma unroll
                for (int d0 = 0; d0 < 4; ++d0)
#pragma unroll
                    for (int r = 0; r < 16; ++r) ob[crow(r, hh_) * 128 + 32 * d0] = o[d0][r];
                if (hh_ == 0) { LAS float* ml = (LAS float*)(lds + 147456); ml[32 * wid + nh] = m; ml[256 + 32 * wid + nh] = l; } }
              __syncthreads();
              { const LAS float* ob = (const LAS float*)lds + wid * 128 + nh;
#pragma unroll
                for (int d0 = 0; d0 < 4; ++d0)
#pragma unroll
                    for (int r = 0; r < 16; ++r) o[d0][r] = ob[8 * crow(r, hh_) * 128 + 32 * d0];
                const LAS float* ml = (const LAS float*)(lds + 147456); m = ml[8 * nh + wid]; l = ml[256 + 8 * nh + wid]; }
#pragma unroll
              for (int d0 = 0; d0 < 8; ++d0) asm volatile("" : "+v"(qr[d0])); }
            __syncthreads();
            {
                const int cls = wid & 3, hh = wid >> 2, kmc = T0 + cls - 512;
                int ts8 = 0; while (ts8 < 3 && T0 + 3 - 512 + 4 * (64 * ts8 + 63) < 0) ++ts8;
                LAS unsigned char* ktl = lds + cls * 16384; LAS unsigned char* vtl = lds + 65536 + cls * 16384;
                int kaddr4[4]; int vb4, nb4;
                { const int lq_ = lane_fresh();
#pragma unroll
                  for (int dd = 0; dd < 4; ++dd) kaddr4[dd] = (int)(uintptr_t)ktl + (lq_ & 31) * 256 + (((2 * dd + (lq_ >> 5)) ^ (lq_ & 7)) << 4);
                  vb4 = (int)(uintptr_t)vtl + v_rd_base(lq_);
                  nb4 = 256 + hh + 32 * (lq_ >> 5) - (lq_ & 31); }
#define ISSUE8K(s_) do { const int l4_ = lane_fresh(); _Pragma("unroll") for (int j = 0; j < 16; ++j) { const int P_ = j * 64 + l4_, row_ = P_ >> 4, col_ = ((P_ & 15) ^ (row_ & 7)) * 8;     \
                    int kp_ = kmc + 4 * (64 * (s_) + row_); kp_ = kp_ < 0 ? 0 : (kp_ > SEQ - 1 ? SEQ - 1 : kp_);                                                       \
                    GLDS16(Kp + (size_t)kp_ * HD + col_, ktl + j * 1024); } } while (0)
#define ISSUE8V(s_) do { const int l4_ = lane_fresh(); _Pragma("unroll") for (int j = 0; j < 16; ++j) { const int P_ = j * 64 + l4_, sb_ = P_ >> 5, kk_ = (sb_ >> 2) * 8 + ((P_ >> 2) & 7);      \
                    const int vrow_ = (kk_ & ~0xC) | ((kk_ & 4) << 1) | ((kk_ & 8) >> 1), vcol_ = (sb_ & 3) * 32 + (P_ & 3) * 8;                                         \
                    int kp_ = kmc + 4 * (64 * (s_) + vrow_); kp_ = kp_ < 0 ? 0 : (kp_ > SEQ - 1 ? SEQ - 1 : kp_);                                                      \
                    GLDS16(Vp + (size_t)kp_ * HD + vcol_, vtl + j * 1024); } } while (0)
                if (hh == 0) ISSUE8K(ts8); else ISSUE8V(ts8);
                for (int s8 = ts8; s8 < 4; ++s8) {
                    if (hh == 0) VMW(0);
                    BAR_LDS();
                    if (hh != 0 && s8 > ts8) ISSUE8V(s8);
                    f32x16 p[2];
                    qk_tile<1>(p, qr, 0, 0, nullptr, kaddr4, hi, gtab + 258 * 16, nb4 - 64 * s8, r32 + 32 * hi, 64);
                    BAR_LDS();
                    if (hh == 0 && s8 + 1 < 4) ISSUE8K(s8 + 1);
                    { const int kp0 = kmc + 256 * s8;
                      if (kp0 < 0) { const float NEG = -__builtin_inff();
#pragma unroll
                          for (int r = 0; r < 16; ++r) { const int kr = kp0 + 4 * (4 * hi + (r & 3) + 8 * (r >> 2)); if (kr < 0) p[0][r] = NEG; if (kr + 128 < 0) p[1][r] = NEG; } } }
                    bf16x8 pa[4];
                    softmax_step<2>(p, m, l, o, pa, xch, r32, hi);
                    if (hh != 0) VMW(0);
                    BAR_LDS();
                    pv_step<4>(o, pa, vb4);
                }
#undef ISSUE8K
#undef ISSUE8V
            }
            __syncthreads();
            {
            int lp_ = lane_fresh();
            const int vb0 = (int)(uintptr_t)kl + v_rd_base(lp_);
            const int kk7 = (lp_ >> 2) & 7, vk0 = (kk7 & 3) + 8 * (kk7 >> 2), vc0 = (lp_ >> 5) * 32 + (lp_ & 3) * 8;
            const int kr32 = lp_ & 31, khi8 = (lp_ >> 5) * 8;
#define BR_KMIN(b_) (t0 - (128 << (2 * (b_))))
#define BR_NT(b_) ((b_) == 1 ? 8 : 5)
#define BR_TS(b_) (BR_KMIN(b_) < 0 ? ((-BR_KMIN(b_)) >> (5 + 2 * (b_))) : 0)
#define LOAD_K(KF, b_, t_) do { int kp_ = BR_KMIN(b_) + ((32 * (t_) + kr32) << (2 * (b_))); kp_ = kp_ < 0 ? 0 : (kp_ > SEQ - 1 ? SEQ - 1 : kp_);          \
                const bf16_t* kr_ = Kp + (size_t)kp_ * HD + khi8; _Pragma("unroll") for (int d0 = 0; d0 < 8; ++d0) KF[d0] = *(const bf16x8*)(kr_ + d0 * 16); } while (0)
#define ISSUE_V(b_, t_, slot_) do { const int km_ = BR_KMIN(b_), ds_ = 2 * (b_); _Pragma("unroll") for (int j = 0; j < 8; ++j) {                       \
                int kp_ = km_ + ((32 * (t_) + vk0 + 4 * ((j >> 1) & 1) + 16 * (j >> 2)) << ds_); kp_ = kp_ < 0 ? 0 : (kp_ > SEQ - 1 ? SEQ - 1 : kp_);   \
                GLDS16(Vp + (size_t)kp_ * HD + vc0 + 64 * (j & 1), kl + (slot_) * 8192 + j * 1024); } } while (0)
#define PSTEP(KC, KN, vs_) do {                                                                                                                          \
                int nb_ = cb, ntl = ct + 1; has_next = true;                                                                                              \
                if (ntl >= BR_NT(cb)) { nb_ = cb + 1; if (nb_ > 2) has_next = false; else ntl = BR_TS(nb_); }                                             \
                if (has_next) { LOAD_K(KN, nb_, ntl); ISSUE_V(nb_, ntl, 1 - (vs_)); VMW(16); } else VMW(0);                                               \
                f32x16 p[1];                                                                                                                              \
                _Pragma("unroll") for (int r = 0; r < 16; ++r) p[0][r] = 0.f;                                                                             \
                { const int qs_ = 16 >> (2 * cb);                                                     \
                  bf16x8 qbp[2]; make_ident(qbp, lane_fresh());                                                                                                   \
                  int lz_ = lane_fresh();                                                                                             \
                  _Pragma("unroll") for (int s2 = 0; s2 < 2; ++s2) { int n0 = 256 + qs_ * (16 * s2 + 8 * (lz_ >> 5)) - (32 * ct + (lz_ & 31)); n0 = n0 < 0 ? 0 : (n0 > 257 ? 257 : n0); \
                      const bf16x8 gf = *(const LAS bf16x8*)(gtab + (cb * 258 + n0) * 16);                                                                  \
                      p[0] = __builtin_amdgcn_mfma_f32_32x32x16_bf16(gf, qbp[s2], p[0], 0, 0, 0); } }                                                       \
                _Pragma("unroll") for (int d0 = 0; d0 < 8; ++d0) p[0] = __builtin_amdgcn_mfma_f32_32x32x16_bf16(KC[d0], qr[d0], p[0], 0, 0, 0);           \
                { const int kp0 = BR_KMIN(cb) + ((32 * ct) << (2 * cb));                                                                                   \
                  if (kp0 < 0) { const float NEG = -__builtin_inff();                                                                                      \
                      _Pragma("unroll") for (int r = 0; r < 16; ++r) if (kp0 + ((4 * hi + (r & 3) + 8 * (r >> 2)) << (2 * cb)) < 0) p[0][r] = NEG; } }     \
                bf16x8 pa[2];                                                                                                                             \
                softmax_step<1>(p, m, l, o, pa, xch, r32, hi);                                                                                            \
                pv_step<2>(o, pa, vb0 + (vs_) * 8192);                                                                                                    \
                cb = nb_; ct = ntl; } while (0)
            int cb = 2, ct = BR_TS(2); bool has_next = true;
            bf16x8 kfA[8], kfB[8];
            LOAD_K(kfA, cb, ct); ISSUE_V(cb, ct, 0);
            for (;;) {
                PSTEP(kfA, kfB, 0); if (!has_next) break;
                PSTEP(kfB, kfA, 1); if (!has_next) break;
            }
#undef PSTEP
#undef LOAD_K
#undef ISSUE_V
#undef BR_KMIN
#undef BR_NT
#undef BR_TS
            }
            store_o(o, l, mix, boff + t0, 16, h * HD, xch, r32, hi);
        }
        }
    }
}

__device__ __forceinline__ void fox_part(const bf16_t* qkv, const float* nbias, const float* gq, const float* gk, unsigned char* mix, LAS unsigned char* lds, int bid, int nb, int wv_, int dbg = 0) {
    const int wid = wv_; int r32, hi; { const int lf_ = lane_fresh(); r32 = lf_ & 31; hi = lf_ >> 5; }
    asm volatile("" : "+s"(gq), "+s"(gk), "+s"(nbias));
    float bq;
    { const int lb_ = lane_fresh(); float a = fmaxf(fabsf(gq[lb_]), fabsf(gq[lb_ + 64])), c = fmaxf(fabsf(gk[lb_]), fabsf(gk[lb_ + 64]));
#pragma unroll
      for (int o_ = 32; o_ >= 1; o_ >>= 1) { a = fmaxf(a, __shfl_xor(a, o_)); c = fmaxf(c, __shfl_xor(c, o_)); }
      bq = 128.0f * 1.02f * a * c; }
    LAS unsigned char* kbuf = lds;
    LAS unsigned char* vbuf = lds + 65536;
    LAS float* nbl = (LAS float*)(lds + 131072);
    LAS float* xch = (LAS float*)(lds + 147456) + wid * 64;
    for (int item = bid; item < NBATCH * NHB * 8; item += nb) {
        const int xj = item & 7, xk = item >> 3, bh = (xj * 8 + (xk >> 3)) & 63, x = (xk & 32) ? 7 - (xk & 7) : (xk & 7), b = bh >> 4, h = bh & 15;
        const size_t boff = (size_t)b * SEQ;
        const bf16_t* Qp = qkv + ((size_t)(48 + h) * NTOK + boff) * HD; const bf16_t* Kp = qkv + ((size_t)(64 + h) * NTOK + boff) * HD; const bf16_t* Vp = qkv + ((size_t)(80 + h) * NTOK + boff) * HD;
        __syncthreads();
        { int ti_ = wid * 64 + lane_fresh();
          const f32x4 n0_ = *(const f32x4*)(nbias + (size_t)bh * SEQ + ti_ * 4), n1_ = *(const f32x4*)(nbias + (size_t)bh * SEQ + (ti_ + NTHREADS) * 4);
          *(LAS f32x4*)(nbl + ti_ * 4) = n0_; *(LAS f32x4*)(nbl + (ti_ + NTHREADS) * 4) = n1_; }
        for (int half = 0; half < 2; ++half) {
            const int qb = half ? 15 - x : x, NT = 4 * (qb + 1), qlo = qb * 256 + wid * 32, qpos = qlo + r32;
            bf16x8 qr[8];
#pragma unroll
            for (int d0 = 0; d0 < 8; ++d0) qr[d0] = *(const bf16x8*)(Qp + (size_t)qpos * HD + d0 * 16 + hi * 8);
            f32x16 o[4]; float m = -1e30f, l = 0.f;
#pragma unroll
            for (int d0 = 0; d0 < 4; ++d0)
#pragma unroll
                for (int r = 0; r < 16; ++r) o[d0][r] = 0.f;
            __syncthreads();
            int lo_ = lane_fresh();
            int kaddr[4]; CoopSrc cs; coop_setup(cs, kaddr, kbuf, wid, lo_, lo_ & 31, lo_ >> 5);
            const int vb00 = (int)(uintptr_t)vbuf + v_rd_base(lo_);
            int t_stop;
            { const float thr = nbl[qb * 256] - 40.0f / C2 - 2.0f * bq; const int tt = lane_fresh(); const bool sk = tt < NT && nbl[64 * tt + 63] < thr;
              t_stop = __builtin_popcountll(__ballot(sk)); if (t_stop > NT - 1) t_stop = NT - 1; }
            coop_tiles<0>(o, m, l, qr, Kp, Vp, NT - 1, NT - t_stop, -1, 0, qpos, qlo, 0u, nbl, nullptr, kbuf, vbuf, kaddr, vb00, cs, xch, wid, r32, hi, nullptr, 0, 0, 1 << 30, dbg, bq);
            store_o(o, l, mix, boff + qb * 256 + wid * 32, 1, (NHA + h) * HD, xch, r32, hi);
        }
    }
}
__device__ __forceinline__ void attn_phase(const bf16_t* qkv, const float* nbias, const float* rel_bias, const float* gq, const float* gk, unsigned char* mix, LAS unsigned char* lds, int bid, int nb, int wv_) {
    dilated_part(qkv, rel_bias, mix, lds, bid, nb, wv_);
    __syncthreads();
    fox_part(qkv, nbias, gq, gk, mix, lds, bid, nb, wv_);
#if ATT_PROBE == 2
    __syncthreads();
    fox_part(qkv, nbias, gq, gk, mix, lds, bid, nb, wv_);
#endif

}
#undef GLDS16
#undef TABIDX
#undef VMW
#undef BAR_LDS
}

namespace peer {
__device__ __forceinline__ void ins16(float (&L)[16], float x) {
#pragma unroll
    for (int k = 15; k >= 1; --k) L[k] = __builtin_amdgcn_fmed3f(L[k - 1], L[k], x);
    L[0] = fmaxf(L[0], x);
}
__device__ __forceinline__ void top16_stream(const float* base, int lane, float (&L)[16]) {
    const float NEG = -__builtin_inff();
#pragma unroll
    for (int k = 0; k < 16; ++k) L[k] = NEG;
#define TK_LOAD(X, j0_) do { _Pragma("unroll") for (int j = 0; j < 16; ++j) X[j] = base[(size_t)((j0_) + j) * 64 + lane]; } while (0)
#define TK_INS(X, j0_) do { _Pragma("unroll") for (int j = 0; j < 16; ++j) ins16(L, __uint_as_float((__float_as_uint(X[j]) & ~127u) | (unsigned)(127 - ((j0_) + j)))); } while (0)
    float xa[16], xb[16];
    TK_LOAD(xa, 0);
    for (int j0 = 0; j0 < 128; j0 += 32) {
        TK_LOAD(xb, j0 + 16);
        TK_INS(xa, j0);
        if (j0 + 32 < 128) TK_LOAD(xa, j0 + 32);
        TK_INS(xb, j0 + 16);
    }
#undef TK_LOAD
#undef TK_INS
}
__device__ __forceinline__ void topk_phase(const float* sct, unsigned char* gd, float* gatec, int* ec, LAS unsigned char* lds, int bid, int nb, int wv_) {
    const int tid = TIDX, wid = wv_, lane = tid & 63;
    LAS int* ent_e = (LAS int*)lds; LAS float* ent_g = (LAS float*)(lds + 64 * 129 * 4);
#pragma unroll
    for (int k = 0; k < 8; ++k) ((LAS unsigned*)(lds + 74240))[wid * 512 + k * 64 + lane] = 0u;
    for (int tile = bid; tile < NTOK / 64; tile += nb) {
        float L1[16], L2[16];
        top16_stream(sct + (size_t)((wid * 2 + 0) * 256 + tile) * 128 * 64, lane, L1);
        top16_stream(sct + (size_t)((wid * 2 + 1) * 256 + tile) * 128 * 64, lane, L2);
        LAS unsigned char* ix1 = lds + 90624 + tid; LAS unsigned char* ix2 = ix1 + 8192;
#pragma unroll
        for (int k = 0; k < 16; ++k) { ix1[k * 512] = (unsigned char)(127u - (__float_as_uint(L1[k]) & 127u)); ix2[k * 512] = (unsigned char)(127u - (__float_as_uint(L2[k]) & 127u)); }
        float Cv[16];
#pragma unroll
        for (int k = 0; k < 16; ++k) Cv[k] = -__builtin_inff();
#pragma unroll
        for (int i = 0; i < 16; ++i)
#pragma unroll
            for (int j = 0; j < 16; ++j) if ((i + 1) * (j + 1) <= 16)
                ins16(Cv, __uint_as_float((__float_as_uint(L1[i] + L2[j]) & ~255u) | (unsigned)(16 * i + j)));
        int Ce[16];
#pragma unroll
        for (int k = 0; k < 16; ++k) { const unsigned id = __float_as_uint(Cv[k]) & 255u; Ce[k] = (int)ix1[(id >> 4) * 512] * NKEYS + (int)ix2[(id & 15u) * 512]; }
        float ex[16], den = 0.f;
#pragma unroll
        for (int k = 0; k < 16; ++k) { ex[k] = __expf(Cv[k] - Cv[0]); den += ex[k]; }
        const float rden = 1.0f / den;
#pragma unroll
        for (int k = 0; k < 16; ++k) { ent_e[lane * 129 + wid * 16 + k] = Ce[k]; ent_g[lane * 129 + wid * 16 + k] = ex[k] * rden; }
        __syncthreads();
        LAS unsigned char* own = lds + 66048;
        LAS unsigned* bm = (LAS unsigned*)(lds + 74240) + wid * 512;
        for (int tt = 0; tt < 8; ++tt) {
            const int tl = wid * 8 + tt; const LAS int* ee = ent_e + tl * 129; const LAS float* gg = ent_g + tl * 129;
            const int ea = ee[lane], eb = ee[lane + 64]; float ga = 0.f, gb = 0.f; bool oa = true, ob = true;
            const unsigned fa = __hip_atomic_fetch_or(bm + (ea >> 5), 1u << (ea & 31), __ATOMIC_RELAXED, __HIP_MEMORY_SCOPE_WORKGROUP);
            const unsigned fb = __hip_atomic_fetch_or(bm + (eb >> 5), 1u << (eb & 31), __ATOMIC_RELAXED, __HIP_MEMORY_SCOPE_WORKGROUP);
            const bool dup = (((fa >> (ea & 31)) | (fb >> (eb & 31))) & 1u) != 0u;
            asm volatile("s_waitcnt lgkmcnt(0)" ::: "memory");
            bm[ea >> 5] = 0u; bm[eb >> 5] = 0u;
            if (!__any(dup)) { ga = gg[lane]; gb = gg[lane + 64]; }
            else
            for (int j = 0; j < 128; ++j) { const int ej = ee[j]; const float gj = gg[j];
                if (ej == ea) { if (j < lane) oa = false; ga += gj; }
                if (ej == eb) { if (j < lane + 64) ob = false; gb += gj; } }
            const size_t trow = (size_t)(tile * 64 + tl);
            own[tl * 128 + lane] = oa ? (unsigned char)(lane + 1) : (unsigned char)0;
            own[tl * 128 + lane + 64] = ob ? (unsigned char)(lane + 65) : (unsigned char)0;
            gatec[trow * 128 + lane] = oa ? ga : 0.f; gatec[trow * 128 + lane + 64] = ob ? gb : 0.f;
            ec[trow * 128 + lane] = ea; ec[trow * 128 + lane + 64] = eb;
        }
        __syncthreads();
        { LAS unsigned char* img = lds + 90624; const int pm = tile >> 2, q4 = tile & 3, ai = q4 >> 1, wr = q4 & 1;
#pragma unroll
          for (int i = 0; i < 8; ++i) *(LAS u32x4*)(img + (tid + NTHREADS * i) * 16) = (u32x4){0u, 0u, 0u, 0u};
          __syncthreads();
          int epk[16];
#pragma unroll
          for (int k2 = 0; k2 < 16; ++k2) { const int idx = tid + NTHREADS * k2, tl = idx >> 7, sl = idx & 127; const unsigned b = own[idx]; const int e = ent_e[tl * 129 + sl];
              const int pnl = (e >> 8) & 3, col = e & 255, m = (tl >> 4) & 3, fr = tl & 15;
              const int off = ((((pnl * 4 + m) * 2 + (col >> 7)) * 4 + ((col >> 5) & 3)) << 9) + fr * 32 + (col & 31);
              epk[k2] = b != 0u ? (((e >> 10) << 24) | (off << 8) | (int)b) : -1; }
          for (int p = 0; p < 16; ++p) {
#pragma unroll
              for (int k2 = 0; k2 < 16; ++k2) if ((epk[k2] >> 24) == p) img[(epk[k2] >> 8) & 0xffff] = (unsigned char)(epk[k2] & 0xff);
              __syncthreads();
#pragma unroll
              for (int i = 0; i < 8; ++i) { const int P = tid + NTHREADS * i, c = P >> 5, wc = c & 3, bj = (c >> 2) & 1, m = (c >> 3) & 3, pnl = c >> 5;
                  unsigned char* dst = gd + (size_t)(pm * 64 + 4 * p + pnl) * 65536 + (size_t)(((ai * 4 + m) * 2 + bj) * 4096 + (wr * 4 + wc) * 512 + (P & 31) * 16);
                  *(u32x4*)dst = *(const LAS u32x4*)(img + P * 16); *(LAS u32x4*)(img + P * 16) = (u32x4){0u, 0u, 0u, 0u}; }
              __syncthreads();
          } }
    }
}
__device__ __forceinline__ void act_phase(const float* pre, const float* gatec, const int* ec, unsigned char* gd, int bid, int nb, int wv_) {
    const size_t st = (size_t)nb * NTHREADS, n = (size_t)NTOK * 128; size_t i = (size_t)bid * NTHREADS + TIDX;
    for (; i + 7 * st < n; i += 8 * st) {
        float gt[8], pr[8]; int ee[8];
#pragma unroll
        for (int q = 0; q < 8; ++q) { gt[q] = gatec[i + q * st]; pr[q] = pre[i + q * st]; ee[q] = ec[i + q * st]; }
#pragma unroll
        for (int q = 0; q < 8; ++q) if (gt[q] != 0.f) { const float a = pg8::gelu1(pr[q]) * gt[q] * 16.0f;
            gd[pg8::gd_off((int)((i + q * st) >> 7), ee[q])] = (unsigned char)(__builtin_amdgcn_cvt_pk_fp8_f32(a, 0.f, 0, false) & 0xff); }
    }
    for (; i < n; i += st) {
        const float gt = gatec[i];
        if (gt != 0.f) { const float a = pg8::gelu1(pre[i]) * gt * 16.0f;
            gd[pg8::gd_off((int)(i >> 7), ec[i])] = (unsigned char)(__builtin_amdgcn_cvt_pk_fp8_f32(a, 0.f, 0, false) & 0xff); }
    }
}
}

__global__ void __launch_bounds__(NTHREADS, 2) hybrid_fwd(Args args) {
    extern __shared__ __attribute__((aligned(16))) unsigned char lds_raw[];
    LAS unsigned char* lds = (LAS unsigned char*)lds_raw;
    const int wv_ = __builtin_amdgcn_readfirstlane((int)threadIdx.x >> 6); const int bid = blockIdx.x, nb = gridDim.x;
    unsigned char* ws = args.ws;
    { const int tid = TIDX; if (tid < 4) ((LAS unsigned*)(lds + LDS_BARW))[tid] = 0u; }
    __syncthreads();
    XcdBarrier bar; bar.bar = (unsigned*)(ws + WS_CTL); bar.x = 0; bar.st = nullptr;
    const int lo = args.ph_lo, hi = args.ph_hi;
    if (hi - lo > 1) bar = xcd_barrier_post((unsigned*)(ws + WS_CTL) + args.bar_idx * XCD_BAR_WORDS, (volatile LAS unsigned*)(lds + LDS_BARW), wv_);
#ifndef PHASE_MASK
#define PHASE_MASK 0x7ff
#endif
#define IN(k) (((PHASE_MASK >> (k)) & 1) && lo <= (k) && (k) < hi)
#define SEAM(k) do { if (IN(k) && IN((k) + 1)) xcd_barrier(bar, wv_); } while (0)
    float* mod = (float*)(ws + WS_MOD);
    bf16_t* H = (bf16_t*)(ws + WS_H);
    bf16_t* QKV = (bf16_t*)(ws + WS_QKV);
    unsigned char* GD = ws + WS_QKV;

    if (IN(0)) { p0_prologue(args, lds, bid, nb, wv_); }
    SEAM(0);
    if (IN(1)) { norm_phase<true, true, false>(karg_in(0), karg_in(4), mod + 0 * DM, mod + 1 * DM, nullptr, ws + WS_H8, (const bf16_t*)(ws + WS_WFZT), karg_in(6), (float*)(ws + WS_LOGF), lds, bid, nb, wv_); }
    SEAM(1);
    if (IN(2)) {
        att2::build_gtab(karg_in(11), (bf16_t*)(ws + WS_GTAB), bid, nb, wv_);
        cumsum_phase((const float*)(ws + WS_LOGF), (float*)(ws + WS_NB), lds + LDS_AUX, bid, nb, wv_);
        pg8::Gemm g{(const bf16_t*)(ws + WS_H8), (const bf16_t*)(ws + WS_WINT), NTOK, NQKV, DM}; pg8::StaticOrder S; S.init(NTOK, NQKV, nb, bid);
        pg8::EpiQKV E{QKV, karg_in(7), karg_in(8), karg_in(9), karg_in(10), (LAS float*)(lds + LDS_AUX), 0.015625f};
        pg8::gemm_phase<pg8::EpiQKV, pg8::StaticOrder, true, true, 1>(lds, g, S, E, wv_);
    }
    SEAM(2);
    if (IN(3)) { att2::attn_phase(QKV, (const float*)(ws + WS_NB), (const float*)(ws + WS_GTAB), karg_in(9), karg_in(10), ws + WS_H8, lds, bid, nb, wv_); }
    SEAM(3);
    if (IN(4)) {
        pg8::Gemm g{(const bf16_t*)(ws + WS_H8), (const bf16_t*)(ws + WS_WOT), NTOK, DM, DM}; pg8::StaticOrder S; S.init(NTOK, DM, nb, bid);
        pg8::EpiResid<false, true> E{karg_in(0), ws + WS_X1, mod + 2 * DM, 1.0f / 1024.0f};
        pg8::gemm_phase<pg8::EpiResid<false, true>, pg8::StaticOrder, true, true, 1>(lds, g, S, E, wv_);
    }
    SEAM(4);
    if (IN(5)) {
        norm_phase<false, true, true, false, true>(ws + WS_X1, karg_in(13), mod + 3 * DM, mod + 4 * DM, H, ws + WS_H8, nullptr, nullptr, nullptr, lds, bid, nb, wv_);
    }
    SEAM(5);
    if (IN(6)) {
        pg8::Gemm g{H, (const bf16_t*)(ws + WS_WCT), NTOK, NSC, DM}; pg8::StaticOrder S; S.init(NTOK, NSC, nb, bid);
        pg8::EpiScoreT E{(float*)(ws + WS_SC)};
        pg8::gemm_phase<pg8::EpiScoreT, pg8::StaticOrder, true, true>(lds, g, S, E, wv_);
    }
    SEAM(6);
    if (IN(7)) {
        { u32x4* z = (u32x4*)(ws + WS_PRE); const size_t n16 = (size_t)NTOK * 128 * 4 / 16;
          for (size_t i = (size_t)bid * NTHREADS + TIDX; i < n16; i += (size_t)nb * NTHREADS) z[i] = (u32x4){0u, 0u, 0u, 0u}; }
        peer::topk_phase((const float*)(ws + WS_SC), GD, (float*)(ws + WS_GATEC), (int*)(ws + WS_EC), lds, bid, nb, wv_);
    }
    SEAM(7);
    if (IN(8)) {
        pg8::Gemm g{(const bf16_t*)(ws + WS_H8), (const bf16_t*)(ws + WS_UB), NTOK, NEXP, DM}; pg8::StaticOrder S; S.init(NTOK, NEXP, nb, bid);
        pg8::EpiSlot E{GD, NEXP, 0.015625f, (float*)(ws + WS_PRE)};
        pg8::gemm_phase<pg8::EpiSlot, pg8::StaticOrder, true, true, 1>(lds, g, S, E, wv_);
    }
    SEAM(8);
    if (IN(9)) { peer::act_phase((const float*)(ws + WS_PRE), (const float*)(ws + WS_GATEC), (const int*)(ws + WS_EC), GD, bid, nb, wv_); }
    SEAM(9);
    if (IN(10)) {
        pg8::Gemm g{(const bf16_t*)GD, (const bf16_t*)(ws + WS_VT), NTOK, DM, NEXP}; pg8::StaticOrder S; S.init(NTOK, DM, nb, bid);
        pg8::EpiResid<true, false> E{ws + WS_X1, (float*)karg_in(19), mod + 5 * DM, 0.0625f};
        pg8::gemm_phase<pg8::EpiResid<true, false>, pg8::StaticOrder, true, true, 1, true>(lds, g, S, E, wv_);
    }
#undef IN
#undef SEAM
}

#if ATT_PROBE == 6
__global__ void __launch_bounds__(NTHREADS, 2) fox_probe(Args args) {
    extern __shared__ __attribute__((aligned(16))) unsigned char lds_raw2[];
    LAS unsigned char* lds = (LAS unsigned char*)lds_raw2;
    const int wv_ = __builtin_amdgcn_readfirstlane((int)threadIdx.x >> 6); unsigned char* ws = args.ws;
    att2::fox_part((const bf16_t*)(ws + WS_QKV), (const float*)(ws + WS_NB), args.in[9], args.in[10], ws + WS_SC, lds, blockIdx.x, gridDim.x, wv_, FOXDBG);
}
#endif
extern "C" void kernel_launch(void* const* d_in, const int* in_sizes, int n_in, void* d_out, int out_size, void* d_ws, size_t ws_size, hipStream_t stream) {
    static int grid = 0;
    if (grid == 0) {
        if (n_in != 19 || out_size != NTOK * DM || ws_size < WS_END) { fprintf(stderr, "kernel_launch: unexpected shapes (n_in %d, out %d, ws %zu < %zu)\n", n_in, out_size, ws_size, (size_t)WS_END); grid = -1; return; }
        int dev = 0, cus = 0, per_cu = 0;
        if (hipGetDevice(&dev) != hipSuccess || hipDeviceGetAttribute(&cus, hipDeviceAttributeMultiprocessorCount, dev) != hipSuccess) { grid = -1; return; }
        if (hipFuncSetAttribute((const void*)hybrid_fwd, hipFuncAttributeMaxDynamicSharedMemorySize, LDS_BYTES) != hipSuccess) { fprintf(stderr, "kernel_launch: hipFuncSetAttribute failed\n"); grid = -1; return; }
        if (hipOccupancyMaxActiveBlocksPerMultiprocessor(&per_cu, (const void*)hybrid_fwd, NTHREADS, LDS_BYTES) != hipSuccess || per_cu < 1) { fprintf(stderr, "kernel_launch: occupancy query says %d\n", per_cu); per_cu = 1; }
        (void)hipGetLastError();
        grid = cus;
    }
    if (grid < 0) return;
    (void)hipMemsetAsync((char*)d_ws + WS_CTL, 0, CTL_ZERO_BYTES, stream);
    Args a{};
    for (int i = 0; i < 19; ++i) a.in[i] = (const float*)d_in[i];
    a.out = (float*)d_out; a.ws = (unsigned char*)d_ws;
#ifndef PROBE_PHASES
#define PROBE_PHASES 0
#endif
    int start = 0, nl = 0;
    for (int k = 0; k < 11; ++k) if ((PROBE_PHASES >> k) & 1) {
        a.ph_lo = start; a.ph_hi = k + 1; a.bar_idx = (k + 1 - start > 1) ? nl++ : 0; hipLaunchKernelGGL(hybrid_fwd, dim3(grid), dim3(NTHREADS), LDS_BYTES, stream, a);
        a.ph_lo = k; a.ph_hi = k + 1; a.bar_idx = 0; hipLaunchKernelGGL(hybrid_fwd, dim3(grid), dim3(NTHREADS), LDS_BYTES, stream, a);
        start = k + 1; }
    if (start < 11) { a.ph_lo = start; a.ph_hi = 11; a.bar_idx = nl++ & 3; hipLaunchKernelGGL(hybrid_fwd, dim3(grid), dim3(NTHREADS), LDS_BYTES, stream, a); }
#if ATT_PROBE == 6
    { static bool once = false; if (!once) { once = true; (void)hipFuncSetAttribute((const void*)fox_probe, hipFuncAttributeMaxDynamicSharedMemorySize, LDS_BYTES); }
      a.pad = FOXDBG; hipLaunchKernelGGL(fox_probe, dim3(grid), dim3(NTHREADS), LDS_BYTES, stream, a); }
#endif
}
```

```cpp
#include <hip/hip_runtime.h>
#include <cstdio>
#include <cstdint>

#define LAS __attribute__((address_space(3)))
typedef unsigned short bf16_t;
typedef short bf16x8 __attribute__((ext_vector_type(8)));
typedef short s16x4 __attribute__((ext_vector_type(4)));
typedef float f32x4 __attribute__((ext_vector_type(4)));
typedef float f32x2 __attribute__((ext_vector_type(2)));
typedef float f32x16 __attribute__((ext_vector_type(16)));
typedef unsigned u32x4 __attribute__((ext_vector_type(4)));
typedef unsigned u32x2 __attribute__((ext_vector_type(2)));
typedef int i32x8 __attribute__((ext_vector_type(8)));
typedef int i32x4 __attribute__((ext_vector_type(4)));
typedef int i32x2 __attribute__((ext_vector_type(2)));
typedef int i32x6 __attribute__((ext_vector_type(6)));
typedef unsigned u32x16 __attribute__((ext_vector_type(16)));
typedef __bf16 bf16x32 __attribute__((ext_vector_type(32)));

constexpr int DM = 4096, NBATCH = 4, SEQ = 4096, NTOK = NBATCH * SEQ, HD = 128, NHA = 16, NHB = 16;
constexpr int NQKV = 12288, INC = 12304, NMOD = 6 * DM;
constexpr int PHEADS = 8, NKEYS = 128, NEXP = 16384, TOPK = 16, NSC = PHEADS * 2 * NKEYS;
constexpr float NORM_EPS = 1e-6f;
constexpr int NTHREADS = 512;
constexpr int LDS_RING = 131072, LDS_AUX = 131072, LDS_BYTES = 163840;
constexpr int LDS_BARW = LDS_BYTES - 64;

constexpr size_t WS_CTL = 0;
constexpr size_t WS_MOD = 65536;
constexpr size_t WS_LOGF = WS_MOD + 393216;
constexpr size_t WS_NB = WS_LOGF + 1048576;
constexpr size_t WS_WFZT = WS_NB + 1048576;
constexpr size_t WS_GTAB = WS_WFZT + 131072;
constexpr size_t WS_H = 4194304;
constexpr size_t WS_WINT = WS_H + 134217728;
constexpr size_t WS_WOT = WS_WINT + 100663296;
constexpr size_t WS_WCT = WS_WOT + 33554432;
constexpr size_t WS_UB = WS_WCT + 16777216;
constexpr size_t WS_VT = WS_UB + 134217728;
constexpr size_t WS_QKV = WS_VT + 134217728;
constexpr size_t WS_SC = WS_QKV + 536870912;
constexpr size_t WS_H8 = WS_SC + 134217728;
constexpr size_t WS_X1 = WS_H8 + 67108864;
constexpr size_t WS_PRE = WS_X1 + 134217728;
constexpr size_t WS_GATEC = WS_PRE + 8388608;
constexpr size_t WS_EC = WS_GATEC + 8388608;
constexpr size_t WS_END = WS_EC + 8388608;
constexpr size_t CTL_ZERO_BYTES = 65536;

struct Args { const float* in[19]; float* out; unsigned char* ws; int ph_lo, ph_hi, bar_idx, pad; };
__device__ __forceinline__ int lane_fresh() { int z = 0; asm volatile("" : "+s"(z)); return (int)__builtin_amdgcn_mbcnt_hi(~0u, __builtin_amdgcn_mbcnt_lo(~0u, (unsigned)z)); }
#define TIDX (wv_ * 64 + lane_fresh())
typedef const __attribute__((address_space(4))) unsigned char* KargP;
__device__ __forceinline__ const float* karg_in(int k) {
    KargP p = (KargP)__builtin_amdgcn_kernarg_segment_ptr(); asm volatile("" : "+s"(p));
    return *(const float* const __attribute__((address_space(4)))*)(p + 8 * k);
}

__device__ __forceinline__ unsigned cvt_pk_bf16(float lo, float hi) { unsigned r; asm volatile("v_cvt_pk_bf16_f32 %0, %1, %2" : "=v"(r) : "v"(lo), "v"(hi)); return r; }
__device__ __forceinline__ u32x2 pack8_fp8(f32x4 a, f32x4 b) { int w0 = __builtin_amdgcn_cvt_pk_fp8_f32(a[0], a[1], 0, false); w0 = __builtin_amdgcn_cvt_pk_fp8_f32(a[2], a[3], w0, true);
    int w1 = __builtin_amdgcn_cvt_pk_fp8_f32(b[0], b[1], 0, false); w1 = __builtin_amdgcn_cvt_pk_fp8_f32(b[2], b[3], w1, true); u32x2 r; r.x = (unsigned)w0; r.y = (unsigned)w1; return r; }
__device__ __forceinline__ void store_fp6_slot(unsigned char* ktile_row, int g, i32x6 pk) {
    *(i32x4*)(ktile_row + 16 * g) = (i32x4){pk[0], pk[1], pk[2], pk[3]}; *(i32x2*)(ktile_row + 64 + 16 * g) = (i32x2){pk[4], pk[5]}; }
__device__ __forceinline__ float bf2f(bf16_t b) { return __uint_as_float(((unsigned)b) << 16); }
__device__ __forceinline__ bf16_t f2bf(float f) { return (bf16_t)(cvt_pk_bf16(f, 0.f) & 0xffffu); }

#define XB_TMO      128
#define XB_XCNT(j)  (256  + 64 * (j))
#define XB_XSUB(j)  (1280 + 64 * (j))
#define XB_XGEN(j)  (2304 + 64 * (j))
#define XB_TOP      3328
#define XB_TOPGEN   3392
#define XCD_BAR_WORDS 3456
#define XB_SPIN_CAP (1u << 22)

__device__ __forceinline__ unsigned xb_ld(unsigned* p)              { return __hip_atomic_load(p, __ATOMIC_RELAXED, __HIP_MEMORY_SCOPE_AGENT); }
__device__ __forceinline__ unsigned xb_add(unsigned* p, unsigned v) { return __hip_atomic_fetch_add(p, v, __ATOMIC_RELAXED, __HIP_MEMORY_SCOPE_AGENT); }
__device__ __forceinline__ unsigned xb_xcc_id() { return (unsigned)__builtin_amdgcn_s_getreg((3 << 11) | 20) & 0xFu; }
#define XB_SPIN(cond, bar) do { unsigned _sp = 0; while (cond) { __builtin_amdgcn_s_sleep(1); \
    if ((++_sp & 255u) == 0u) { if (xb_ld(&(bar)[XB_TMO])) break; if (_sp > XB_SPIN_CAP) { atomicAdd(&(bar)[XB_TMO], 1u); break; } } } } while (0)

struct XcdBarrier { unsigned* bar; unsigned x; volatile LAS unsigned* st; };

__device__ __forceinline__ XcdBarrier xcd_barrier_post(unsigned* bar, volatile LAS unsigned* st, int wv_) {
    XcdBarrier b; b.bar = bar; b.x = xb_xcc_id(); b.st = st;
    if (wv_ == 0 && lane_fresh() == 0) (void)xb_add(&bar[XB_XCNT(b.x)], 1u);
    return b;
}
__device__ __forceinline__ void xcd_barrier_complete(unsigned* bar, unsigned x, unsigned& nloc, unsigned& nx) {
    const unsigned G = gridDim.x * gridDim.y * gridDim.z;
    unsigned sum, cnt, mine, sp = 0u;
    for (;;) {
        sum = 0u; cnt = 0u; mine = 0u;
#pragma unroll
        for (unsigned j = 0; j < 16; ++j) { const unsigned c = xb_ld(&bar[XB_XCNT(j)]); sum += c; cnt += (c > 0u) ? 1u : 0u; mine = (j == x) ? c : mine; }
        if (sum == G) break;
        __builtin_amdgcn_s_sleep(1);
        if ((++sp & 255u) == 0u) { if (xb_ld(&bar[XB_TMO])) break; if (sp > XB_SPIN_CAP) { atomicAdd(&bar[XB_TMO], 1u); break; } }
    }
    nloc = mine > 0u ? mine : 1u; nx = cnt > 0u ? cnt : 1u;
}
__device__ __forceinline__ void xcd_barrier(const XcdBarrier& b, int wv_) {
    asm volatile("s_waitcnt vmcnt(0)" ::: "memory");
    __syncthreads();
    if (wv_ == 0 && lane_fresh() == 0) {
        unsigned* bar = b.bar;
        __builtin_amdgcn_s_waitcnt(0);
        unsigned nloc = b.st[0], nx = b.st[1];
        if (nloc == 0u) { xcd_barrier_complete(bar, b.x, nloc, nx); b.st[0] = nloc; b.st[1] = nx; }
        const unsigned old = xb_add(&bar[XB_XSUB(b.x)], 1u);
        const unsigned gen = old / nloc;
        if (old + 1u == (gen + 1u) * nloc) {
            __builtin_amdgcn_fence(__ATOMIC_RELEASE, "agent");
            asm volatile("s_waitcnt vmcnt(0)" ::: "memory");
            const unsigned og = xb_add(&bar[XB_TOP], 1u);
            const unsigned tg = og / nx;
            if (og + 1u == (tg + 1u) * nx) xb_add(&bar[XB_TOPGEN], 1u);
            else XB_SPIN(xb_ld(&bar[XB_TOPGEN]) == tg, bar);
            __builtin_amdgcn_fence(__ATOMIC_ACQUIRE, "agent");
            xb_add(&bar[XB_XGEN(b.x)], 1u);
            asm volatile("s_waitcnt vmcnt(0)" ::: "memory");
        } else {
            XB_SPIN(xb_ld(&bar[XB_XGEN(b.x)]) == gen, bar);
            __builtin_amdgcn_fence(__ATOMIC_ACQUIRE, "agent");
            asm volatile("s_waitcnt vmcnt(0)" ::: "memory");
        }
    }
    __syncthreads();
}

namespace pg8 {
constexpr int BM = 256, BK = 64, HALF = 128, HTB = HALF * BK * 2, STAGE_BYTES = 8 * HTB, NXCD = 8, WGM = 4;
__host__ __device__ __forceinline__ int lds_byte(int r, int c) { const int st = (r >> 4) * 2 + (c >> 5), rr = r & 15, cc = c & 31, ob = rr * 64 + cc * 2; return st * 1024 + (ob ^ (((ob >> 9) & 1) << 5)); }
__host__ __device__ __forceinline__ void stage_rc(int b, int& R, int& C) { const int st = b / 1024, sb = b % 1024, swz = sb ^ (((sb >> 9) & 1) << 5); R = (st >> 1) * 16 + swz / 64; C = (st & 1) * 32 + (swz % 64) / 2; }
__host__ __device__ __forceinline__ int perm32(int rho) { const int n = rho >> 4, i = rho & 15; return 8 * (i >> 2) + 4 * n + (i & 3); }

struct Unit { int pm, pn; };
struct Gemm { const bf16_t* A; const bf16_t* Bt; int M, N, K; };

struct StaticOrder {
    int nM, nN, nwg, G, c;
    __host__ __device__ void init(int M, int N, int G_, int c_) { nM = M / BM; nN = N / BM; nwg = nM * nN; G = G_; c = c_; }
    __host__ __device__ bool next(int i, Unit& u) const {
        const long L = (long)i * G + c; if (L >= nwg) return false;
        int wgid = (int)L; { const int q = nwg / NXCD, r = nwg % NXCD, xcd = wgid % NXCD, off = wgid / NXCD; wgid = (xcd < r ? xcd * (q + 1) : r * (q + 1) + (xcd - r) * q) + off; }
        const int nig = WGM * nN, gid = wgid / nig, fm = gid * WGM, gsz = (nM - fm) < WGM ? (nM - fm) : WGM;
        u.pm = fm + ((wgid % nig) % gsz); u.pn = (wgid % nig) / gsz; return true;
    }
    __device__ __forceinline__ void a_ready(const Unit&) const {}
    __device__ __forceinline__ void done(const Unit&) const {}
};

__device__ __forceinline__ f32x2 gelu_pk(f32x2 v) {
    const f32x2 av = __builtin_elementwise_abs(v), d = av * 0.2316418882f + 1.0f;
    f32x2 t; t.x = __builtin_amdgcn_rcpf(d.x); t.y = __builtin_amdgcn_rcpf(d.y);
    f32x2 q = t * 0.5307027145f + (-0.7265760135f); q = q * t + 0.7107068705f; q = q * t + (-0.142248368f); q = q * t + 0.127414796f; q = q * t;
    const f32x2 s = (v * v) * (-0.72134752044f);
    f32x2 e; e.x = __builtin_amdgcn_exp2f(s.x); e.y = __builtin_amdgcn_exp2f(s.y);
    const f32x2 m = v * (q * e), r = v - m;
    f32x2 o; o.x = v.x < 0.f ? m.x : r.x; o.y = v.y < 0.f ? m.y : r.y; return o;
}

__device__ __forceinline__ float gelu1(float v) {
    const float av = __builtin_fabsf(v), t = __builtin_amdgcn_rcpf(av * 0.2316418882f + 1.0f);
    float q = t * 0.5307027145f + (-0.7265760135f); q = q * t + 0.7107068705f; q = q * t + (-0.142248368f); q = q * t + 0.127414796f; q = q * t;
    const float e = __builtin_amdgcn_exp2f((v * v) * (-0.72134752044f)), m = v * (q * e);
    return v < 0.f ? m : v - m;
}

struct EpiQKV {
    static constexpr bool PERM = true, AFTER_DRAIN = false;
    bf16_t* O; const float* gqa; const float* gka; const float* gqb; const float* gkb; LAS float* P; float scale;
    __device__ __forceinline__ void operator()(f32x4 (&acc)[2][2][4][2], const Unit& u, int wr, int wc, int fr, int fq) const {
        const int grp = u.pn >> 3;
        const float* gain = grp == 0 ? gqa : grp == 1 ? gka : grp == 3 ? gqb : grp == 4 ? gkb : nullptr;
#pragma unroll
        for (int ai = 0; ai < 2; ++ai)
#pragma unroll
            for (int bj = 0; bj < 2; ++bj)
#pragma unroll
                for (int m = 0; m < 4; ++m)
#pragma unroll
                    for (int n = 0; n < 2; ++n) acc[ai][bj][m][n] = acc[ai][bj][m][n] * scale;
        if (gain) {
#pragma unroll
            for (int ai = 0; ai < 2; ++ai)
#pragma unroll
                for (int m = 0; m < 4; ++m)
#pragma unroll
                    for (int bj = 0; bj < 2; ++bj) {
                        const f32x4 a = acc[ai][bj][m][0], b = acc[ai][bj][m][1];
                        float s = (a[0] * a[0] + a[1] * a[1]) + (a[2] * a[2] + a[3] * a[3]) + (b[0] * b[0] + b[1] * b[1]) + (b[2] * b[2] + b[3] * b[3]);
                        s += __shfl_xor(s, 16); s += __shfl_xor(s, 32);
                        if (fq == 0) P[((ai * HALF + wr * 64 + m * 16 + fr) * 2 + bj) * 4 + wc] = s;
                    }
            asm volatile("s_waitcnt lgkmcnt(0)" ::: "memory"); __builtin_amdgcn_s_barrier(); asm volatile("" ::: "memory");
            f32x4 g0 = *(const f32x4*)(gain + wc * 32 + 8 * fq), g1 = *(const f32x4*)(gain + wc * 32 + 8 * fq + 4);
#pragma unroll
            for (int ai = 0; ai < 2; ++ai)
#pragma unroll
                for (int m = 0; m < 4; ++m)
#pragma unroll
                    for (int bj = 0; bj < 2; ++bj) {
                        const f32x4 pp = *(const LAS f32x4*)(P + ((ai * HALF + wr * 64 + m * 16 + fr) * 2 + bj) * 4);
                        const float rinv = __builtin_amdgcn_rsqf(((pp[0] + pp[1]) + (pp[2] + pp[3])) * (1.0f / 128.0f) + NORM_EPS);
                        acc[ai][bj][m][0] = acc[ai][bj][m][0] * rinv * g0; acc[ai][bj][m][1] = acc[ai][bj][m][1] * rinv * g1;
                    }
        }
#pragma unroll
        for (int ai = 0; ai < 2; ++ai)
#pragma unroll
            for (int m = 0; m < 4; ++m) { const size_t row = (size_t)(u.pm * BM + ai * HALF + wr * 64 + m * 16 + fr);
#pragma unroll
                for (int bj = 0; bj < 2; ++bj) { const f32x4 v0 = acc[ai][bj][m][0], v1 = acc[ai][bj][m][1];
                    u32x4 w; w.x = cvt_pk_bf16(v0[0], v0[1]); w.y = cvt_pk_bf16(v0[2], v0[3]); w.z = cvt_pk_bf16(v1[0], v1[1]); w.w = cvt_pk_bf16(v1[2], v1[3]);
                    *(u32x4*)(O + ((size_t)(u.pn * 2 + bj) * NTOK + row) * HD + wc * 32 + 8 * fq) = w; } }
        if (gain) { asm volatile("s_waitcnt lgkmcnt(0)" ::: "memory"); __builtin_amdgcn_s_barrier(); asm volatile("" ::: "memory"); }
    }
};
__device__ __forceinline__ f32x4 unpack4_bf16(u32x2 w) { return (f32x4){__uint_as_float(w.x << 16), __uint_as_float(w.x & 0xffff0000u), __uint_as_float(w.y << 16), __uint_as_float(w.y & 0xffff0000u)}; }
template <bool BF> struct ErVec { typedef f32x4 type; };
template <> struct ErVec<true> { typedef u32x2 type; };
__device__ __forceinline__ f32x4 er_to4(u32x2 w) { return unpack4_bf16(w); }
__device__ __forceinline__ f32x4 er_to4(f32x4 v) { return v; }
template <bool BASE_BF16, bool OUT_BF16>
struct EpiResid {
    static constexpr bool PERM = false, AFTER_DRAIN = false;
    const void* base; void* out; const float* gate; float scale;
    __device__ __forceinline__ void operator()(f32x4 (&acc)[2][2][4][2], const Unit& u, int wr, int wc, int fr, int fq) const {
        const int row0 = u.pm * BM + wr * 64 + fr, col0 = u.pn * BM + wc * 32 + 4 * fq;
        const float* gp = gate + (size_t)(u.pm >> 4) * NMOD + col0;
        f32x4 gv[2][2];
#pragma unroll
        for (int bj = 0; bj < 2; ++bj)
#pragma unroll
            for (int n = 0; n < 2; ++n) gv[bj][n] = *(const f32x4*)(gp + bj * HALF + n * 16) * scale;
#define ER_OFF(ai, mh, m2, bj, n) ((size_t)(row0 + (ai) * HALF + ((mh) * 2 + (m2)) * 16) * DM + col0 + (bj) * HALF + (n) * 16)
#define ER_LOAD(BS, ai, mh) do { _Pragma("unroll") for (int m2 = 0; m2 < 2; ++m2) _Pragma("unroll") for (int bj = 0; bj < 2; ++bj) _Pragma("unroll") for (int n = 0; n < 2; ++n)       \
            BS[m2][bj][n] = *(const BT*)((const char*)base + ER_OFF(ai, mh, m2, bj, n) * (BASE_BF16 ? 2 : 4)); } while (0)
#define ER_PROC(BS, ai, mh) do { _Pragma("unroll") for (int m2 = 0; m2 < 2; ++m2) _Pragma("unroll") for (int bj = 0; bj < 2; ++bj) _Pragma("unroll") for (int n = 0; n < 2; ++n) {     \
            const size_t off = ER_OFF(ai, mh, m2, bj, n); const f32x4 r = er_to4(BS[m2][bj][n]) + gv[bj][n] * acc[ai][bj][(mh) * 2 + m2][n];                                          \
            if constexpr (OUT_BF16) { u32x2 w; w.x = cvt_pk_bf16(r[0], r[1]); w.y = cvt_pk_bf16(r[2], r[3]); *(u32x2*)((bf16_t*)out + off) = w; } else *(f32x4*)((float*)out + off) = r; } \
            asm volatile("" ::: "memory"); } while (0)
        using BT = typename ErVec<BASE_BF16>::type;
        BT bA[2][2][2];
        if constexpr (BASE_BF16) {
            BT bB[2][2][2], bC[2][2][2];
            ER_LOAD(bA, 0, 0); ER_LOAD(bB, 0, 1); ER_LOAD(bC, 1, 0); asm volatile("" ::: "memory");
            ER_PROC(bA, 0, 0); ER_LOAD(bA, 1, 1); asm volatile("" ::: "memory");
            ER_PROC(bB, 0, 1); ER_PROC(bC, 1, 0); ER_PROC(bA, 1, 1);
        } else {
            ER_LOAD(bA, 0, 0); ER_PROC(bA, 0, 0); ER_LOAD(bA, 0, 1); ER_PROC(bA, 0, 1);
            ER_LOAD(bA, 1, 0); ER_PROC(bA, 1, 0); ER_LOAD(bA, 1, 1); ER_PROC(bA, 1, 1);
        }
#undef ER_OFF
#undef ER_LOAD
#undef ER_PROC
    }
};
struct EpiF32 {
    static constexpr bool PERM = false, AFTER_DRAIN = false;
    float* C; int ldc;
    __device__ __forceinline__ void operator()(f32x4 (&acc)[2][2][4][2], const Unit& u, int wr, int wc, int fr, int fq) const {
        const int row0 = u.pm * BM + wr * 64 + fr, col0 = u.pn * BM + wc * 32 + 4 * fq;
#pragma unroll
        for (int ai = 0; ai < 2; ++ai)
#pragma unroll
            for (int m = 0; m < 4; ++m) { float* rowp = C + (size_t)(row0 + ai * HALF + m * 16) * ldc + col0;
#pragma unroll
                for (int bj = 0; bj < 2; ++bj)
#pragma unroll
                    for (int n = 0; n < 2; ++n) *(f32x4*)(rowp + bj * HALF + n * 16) = acc[ai][bj][m][n]; }
    }
};
struct EpiScoreT {
    static constexpr bool PERM = false, AFTER_DRAIN = false;
    float* C;
    __device__ __forceinline__ void operator()(f32x4 (&acc)[2][2][4][2], const Unit& u, int wr, int wc, int fr, int fq) const {
#pragma unroll
        for (int ai = 0; ai < 2; ++ai)
#pragma unroll
            for (int bj = 0; bj < 2; ++bj) { float* base = C + ((size_t)((u.pn * 2 + bj) * 256 + (u.pm * 4 + ai * 2 + wr)) * 128 + wc * 32 + 4 * fq) * 64 + fr;
#pragma unroll
                for (int m = 0; m < 4; ++m)
#pragma unroll
                    for (int n = 0; n < 2; ++n)
#pragma unroll
                        for (int i = 0; i < 4; ++i) base[(n * 16 + i) * 64 + m * 16] = acc[ai][bj][m][n][i]; }
    }
};
__host__ __device__ __forceinline__ size_t gd_off(int row, int e) {
    const int pm = row >> 8, r = row & 255, ai = r >> 7, wr = (r >> 6) & 1, m = (r >> 4) & 3, fr = r & 15;
    const int pn = e >> 8, ec = e & 255, bj = ec >> 7, wc = (ec >> 5) & 3, fqh = (ec >> 4) & 1, b16 = ec & 15;
    return ((((((size_t)(pm * 64 + pn) * 2 + ai) * 4 + m) * 2 + bj) * 8 + (wr * 4 + wc)) * 16 + fr) * 32 + fqh * 16 + b16;
}
struct EpiSlot {
    static constexpr bool PERM = true, AFTER_DRAIN = false;
    const unsigned char* G; int ldc; float ascale; float* pre;
    __device__ __forceinline__ void operator()(f32x4 (&acc)[2][2][4][2], const Unit& u, int wr, int wc, int fr, int fq) const {
        const int row0 = u.pm * BM + wr * 64 + fr;
        const unsigned char* base = G + ((size_t)(u.pm * 64 + u.pn) * 65536) + (size_t)(wr * 4 + wc) * 512 + fr * 32 + fq * 8;
        u32x2 gw[2][4][2];
#pragma unroll
        for (int ai = 0; ai < 2; ++ai)
#pragma unroll
            for (int m = 0; m < 4; ++m)
#pragma unroll
                for (int bj = 0; bj < 2; ++bj) gw[ai][m][bj] = *(const u32x2*)(base + ((ai * 4 + m) * 2 + bj) * 4096);
#pragma unroll
        for (int ai = 0; ai < 2; ++ai)
#pragma unroll
            for (int m = 0; m < 4; ++m)
#pragma unroll
                for (int bj = 0; bj < 2; ++bj) {
                    const u32x2 g = gw[ai][m][bj];
                    if ((g.x | g.y) != 0u) {
                        float* prow = pre + (size_t)(row0 + ai * HALF + m * 16) * 128 - 1;
#pragma unroll
                        for (int e = 0; e < 8; ++e) { const unsigned sl = ((e < 4 ? g.x : g.y) >> (8 * (e & 3))) & 0xffu;
                            if (sl) prow[sl] = acc[ai][bj][m][e >> 2][e & 3] * ascale; }
                    }
                }
    }
};

template <class Epi, class Sched, bool ALIGN_EPI = false, bool SP2 = false, int ES = 2, bool ATILE = false>
__device__ __forceinline__ void gemm_phase(LAS unsigned char* lds, const Gemm g, const Sched& S, const Epi& E, int wv_) {
    int tid_o = TIDX;
    const int tid = tid_o, wid = wv_, lane = tid & 63, wr = wid >> 2, wc = wid & 3, fr = lane & 15, fq = lane >> 4;
    const int K = g.K * (ES == 2 ? 2 : 1) / 2  , nt = K / BK;
    unsigned voffA[2], voffB[2];
#pragma unroll
    for (int i = 0; i < 2; ++i) { int R, C; stage_rc(tid * 16 + i * 8192, R, C); const int Rb = Epi::PERM ? ((R & ~31) + perm32(R & 31)) : R;
        voffA[i] = ATILE ? (unsigned)(((R >> 4) & 3) * 8192 + (R >> 6) * 2048 + (R & 15) * 32 + ((C >> 3) >> 1) * 512 + ((C >> 3) & 1) * 16) : (unsigned)(R * K + C) * 2u;
        voffB[i] = (unsigned)(Rb * K + C) * 2u; }
    const size_t kstep = (size_t)(BK * 2);
    const size_t hstep = (size_t)HALF * K * 2;
    const size_t tstep = 2 * hstep;
    const size_t hstepA = ATILE ? (size_t)32768 : hstep;
#define PG8_KA(t_) (ATILE ? ((size_t)((t_) >> 1) * 65536 + (size_t)((t_) & 1) * 4096) : (size_t)(t_) * kstep)
    const unsigned ldsw = (unsigned)wid * 1024u;
    const int aoff = lds_byte(wr * 64 + fr, fq * 8), boff = lds_byte(wc * 32 + fr, fq * 8);
#define PG8_SA(b, h) (((b) * 2 + (h)) * HTB)
#define PG8_SB(b, h) ((4 + (b) * 2 + (h)) * HTB)
#define PG8_STAGE(bufoff, gbase, voff) do { _Pragma("unroll") for (int _i = 0; _i < 2; ++_i) \
        __builtin_amdgcn_global_load_lds((const unsigned*)((const char*)(gbase) + (voff)[_i]), (LAS unsigned*)(lds + (bufoff) + ldsw + _i * 8192), 16, 0, 0); } while (0)
#define PG8_RD(off) (*(const LAS bf16x8*)(lds + (off)))
#define PG8_CAT2(x, y) __builtin_shufflevector(__builtin_bit_cast(i32x4, (x)), __builtin_bit_cast(i32x4, (y)), 0, 1, 2, 3, 4, 5, 6, 7)
#define PG8_RD6(off) __builtin_shufflevector(__builtin_shufflevector(*(const LAS i32x4*)(lds + (off)), *(const LAS i32x4*)(lds + (off)), 0, 1, 2, 3, -1, -1), \
                                             __builtin_shufflevector(*(const LAS i32x2*)(lds + (off) + 1024), *(const LAS i32x2*)(lds + (off) + 1024), 0, 1, -1, -1, -1, -1), 0, 1, 2, 3, 6, 7)
#define PG8_LDA(dst, b, h) do { _Pragma("unroll") for (int m = 0; m < 4; ++m) { const int o_ = PG8_SA(b, h) + aoff + m * 2048; \
        if constexpr (ES == 2) { dst[m][0] = PG8_RD(o_); dst[m][1] = PG8_RD(o_ + 1024); } else if constexpr (ES == 1) dst##8[m] = PG8_CAT2(PG8_RD(o_), PG8_RD(o_ + 1024)); else dst##6[m] = PG8_RD6(o_); } } while (0)
#define PG8_LDB(dst, b, h) do { _Pragma("unroll") for (int n = 0; n < 2; ++n) { const int o_ = PG8_SB(b, h) + boff + n * 2048; \
        if constexpr (ES == 2) { dst[n][0] = PG8_RD(o_); dst[n][1] = PG8_RD(o_ + 1024); } else if constexpr (ES == 1) dst##8[n] = PG8_CAT2(PG8_RD(o_), PG8_RD(o_ + 1024)); else dst##6[n] = PG8_RD6(o_); } } while (0)
#define PG8_MMA(ai, bj, At, Bt) do { __builtin_amdgcn_s_setprio(1); _Pragma("unroll") for (int m = 0; m < 4; ++m) _Pragma("unroll") for (int n = 0; n < 2; ++n) { \
        if constexpr (ES == 2) { _Pragma("unroll") for (int k = 0; k < 2; ++k) acc[ai][bj][m][n] = __builtin_amdgcn_mfma_f32_16x16x32_bf16(Bt[n][k], At[m][k], acc[ai][bj][m][n], 0, 0, 0); } \
        else if constexpr (ES == 1) asm volatile("v_mfma_f32_16x16x128_f8f6f4 %0, %1, %2, %0" : "+v"(acc[ai][bj][m][n]) : "v"(Bt##8[n]), "v"(At##8[m])); \
        else asm volatile("v_mfma_f32_16x16x128_f8f6f4 %0, %1, %2, %0 cbsz:2 blgp:2" : "+v"(acc[ai][bj][m][n]) : "v"(Bt##6[n]), "v"(At##6[m])); } \
        __builtin_amdgcn_s_setprio(0); } while (0)
#define PG8_WAIT_V(n) asm volatile("s_waitcnt vmcnt(" #n ")" ::: "memory")
#define PG8_WAIT_L(n) asm volatile("s_waitcnt lgkmcnt(" #n ")" ::: "memory")
#define PG8_BAR __builtin_amdgcn_s_barrier()
#define PG8_SCHED __builtin_amdgcn_sched_barrier(0)
    Unit cur, nxt; int ui = 0;
    if (!S.next(0, cur)) return;
    f32x4 acc[2][2][4][2];
#pragma unroll
    for (int a = 0; a < 2; ++a)
#pragma unroll
        for (int b = 0; b < 2; ++b)
#pragma unroll
            for (int m = 0; m < 4; ++m)
#pragma unroll
                for (int n = 0; n < 2; ++n) acc[a][b][m][n] = (f32x4){0.f, 0.f, 0.f, 0.f};
    bf16x8 At[4][2], B0[2][2], B1[2][2]; i32x8 At8[4], B08[2], B18[2]; i32x6 At6[4], B06[2], B16[2];
    const char* cA = (const char*)g.A + (size_t)cur.pm * tstep; const char* cB = (const char*)g.Bt + (size_t)cur.pn * tstep;
    S.a_ready(cur);
    if constexpr (SP2) {
        PG8_STAGE(PG8_SB(0, 0), cB, voffB); PG8_STAGE(PG8_SB(0, 1), cB + hstep, voffB); PG8_STAGE(PG8_SA(0, 0), cA, voffA); PG8_STAGE(PG8_SA(0, 1), cA + hstepA, voffA);
        if (wr == 1) PG8_BAR;
        PG8_WAIT_V(2); PG8_BAR;
        PG8_STAGE(PG8_SB(1, 0), cB + kstep, voffB); PG8_STAGE(PG8_SA(1, 0), cA + PG8_KA(1), voffA); PG8_STAGE(PG8_SB(1, 1), cB + hstep + kstep, voffB);
        PG8_WAIT_V(6); PG8_BAR;
    } else {
        PG8_STAGE(PG8_SB(0, 0), cB, voffB); PG8_STAGE(PG8_SA(0, 0), cA, voffA); PG8_STAGE(PG8_SB(0, 1), cB + hstep, voffB); PG8_STAGE(PG8_SA(0, 1), cA + hstepA, voffA);
        if (wr == 1) PG8_BAR;
        PG8_WAIT_V(4); PG8_BAR;
        PG8_STAGE(PG8_SB(1, 0), cB + kstep, voffB); PG8_STAGE(PG8_SA(1, 0), cA + PG8_KA(1), voffA); PG8_STAGE(PG8_SB(1, 1), cB + hstep + kstep, voffB);
        PG8_WAIT_V(6); PG8_BAR;
    }
    for (;;) {
        const bool has_next = S.next(ui + 1, nxt);
        const char* nA = has_next ? (const char*)g.A + (size_t)nxt.pm * tstep : cA; const char* nB = has_next ? (const char*)g.Bt + (size_t)nxt.pn * tstep : cB;
        for (int t = 0; t < nt; t += 2) {
            const bool last = (t == nt - 2);
            const char* a1 = cA + PG8_KA(t + 1);
            const char* a2 = last ? nA : cA + PG8_KA(t + 2); const char* b2 = last ? nB : cB + (size_t)(t + 2) * kstep;
            const char* a3 = a2 + PG8_KA(1); const char* b3 = b2 + kstep;
            if (last && has_next) S.a_ready(nxt);
            if constexpr (SP2) {
            PG8_LDB(B0, 0, 0); PG8_LDB(B1, 0, 1); PG8_SCHED; PG8_LDA(At, 0, 0); PG8_STAGE(PG8_SA(1, 1), a1 + hstepA, voffA);
            PG8_WAIT_V(8); PG8_WAIT_L(0); PG8_BAR; PG8_MMA(0, 0, At, B0); PG8_MMA(0, 1, At, B1); PG8_BAR; PG8_SCHED;
            PG8_LDA(At, 0, 1); PG8_STAGE(PG8_SB(0, 0), b2, voffB); PG8_STAGE(PG8_SB(0, 1), b2 + hstep, voffB); PG8_STAGE(PG8_SA(0, 0), a2, voffA);
            PG8_WAIT_V(8); PG8_WAIT_L(0); PG8_BAR; PG8_MMA(1, 0, At, B0); PG8_MMA(1, 1, At, B1); PG8_BAR; PG8_SCHED;
            PG8_LDB(B0, 1, 0); PG8_LDB(B1, 1, 1); PG8_SCHED; PG8_LDA(At, 1, 0); PG8_STAGE(PG8_SA(0, 1), a2 + hstepA, voffA);
            PG8_WAIT_V(8); PG8_WAIT_L(0); PG8_BAR; PG8_MMA(0, 0, At, B0); PG8_MMA(0, 1, At, B1); PG8_BAR; PG8_SCHED;
            PG8_LDA(At, 1, 1); PG8_STAGE(PG8_SB(1, 0), b3, voffB); PG8_STAGE(PG8_SB(1, 1), b3 + hstep, voffB); PG8_STAGE(PG8_SA(1, 0), a3, voffA);
            PG8_WAIT_V(8); PG8_WAIT_L(0); PG8_BAR; PG8_MMA(1, 0, At, B0); PG8_MMA(1, 1, At, B1); PG8_BAR; PG8_SCHED;
            } else {
            PG8_LDB(B0, 0, 0); PG8_SCHED; PG8_LDA(At, 0, 0); PG8_STAGE(PG8_SA(1, 1), a1 + hstepA, voffA);
            PG8_WAIT_L(8); PG8_BAR; PG8_WAIT_L(0); PG8_MMA(0, 0, At, B0); PG8_BAR; PG8_SCHED;
            PG8_LDB(B1, 0, 1); PG8_STAGE(PG8_SB(0, 0), b2, voffB);
            PG8_BAR; PG8_WAIT_L(0); PG8_MMA(0, 1, At, B1); PG8_BAR;
            PG8_LDA(At, 0, 1); PG8_STAGE(PG8_SA(0, 0), a2, voffA);
            PG8_BAR; PG8_WAIT_L(0); PG8_MMA(1, 0, At, B0); PG8_BAR; PG8_SCHED;
            PG8_STAGE(PG8_SB(0, 1), b2 + hstep, voffB);
            PG8_WAIT_V(6); PG8_BAR; PG8_MMA(1, 1, At, B1); PG8_BAR;
            PG8_LDB(B0, 1, 0); PG8_SCHED; PG8_LDA(At, 1, 0); PG8_STAGE(PG8_SA(0, 1), a2 + hstepA, voffA);
            PG8_WAIT_L(8); PG8_BAR; PG8_WAIT_L(0); PG8_MMA(0, 0, At, B0); PG8_BAR; PG8_SCHED;
            PG8_LDB(B1, 1, 1); PG8_STAGE(PG8_SB(1, 0), b3, voffB);
            PG8_BAR; PG8_WAIT_L(0); PG8_MMA(0, 1, At, B1); PG8_BAR;
            PG8_LDA(At, 1, 1); PG8_STAGE(PG8_SA(1, 0), a3, voffA);
            PG8_BAR; PG8_WAIT_L(0); PG8_MMA(1, 0, At, B0); PG8_BAR; PG8_SCHED;
            PG8_STAGE(PG8_SB(1, 1), b3 + hstep, voffB);
            PG8_WAIT_V(6); PG8_BAR; PG8_MMA(1, 1, At, B1); PG8_BAR;
            }
        }
        if constexpr (ES != 2) asm volatile("s_nop 15\n\ts_nop 15" ::: "memory");
        if constexpr (ALIGN_EPI) { if (wr == 0) PG8_BAR; }
        if constexpr (!Epi::AFTER_DRAIN) { E(acc, cur, wr, wc, fr, fq); S.done(cur); }
        if (!has_next) break;
#pragma unroll
        for (int a = 0; a < 2; ++a)
#pragma unroll
            for (int b = 0; b < 2; ++b)
#pragma unroll
                for (int m = 0; m < 4; ++m)
#pragma unroll
                    for (int n = 0; n < 2; ++n) acc[a][b][m][n] = (f32x4){0.f, 0.f, 0.f, 0.f};
        cur = nxt; cA = nA; cB = nB; ++ui;
        if constexpr (ALIGN_EPI) { if (wr == 1) PG8_BAR; }
    }
    PG8_WAIT_V(0);
    if constexpr (!ALIGN_EPI) { if (wr == 0) PG8_BAR; }
    PG8_BAR;
#undef PG8_SA
#undef PG8_KA
#undef PG8_SB
#undef PG8_STAGE
#undef PG8_LDA
#undef PG8_LDB
#undef PG8_MMA
#undef PG8_CAT2
#undef PG8_RD
#undef PG8_RD6
#undef PG8_WAIT_V
#undef PG8_WAIT_L
#undef PG8_BAR
#undef PG8_SCHED
}
}

__device__ __forceinline__ float wave_sum(float v) {
#pragma unroll
    for (int o = 32; o >= 1; o >>= 1) v += __shfl_xor(v, o);
    return v;
}
__device__ __forceinline__ u32x2 pack4(f32x4 v) { u32x2 w; w.x = cvt_pk_bf16(v[0], v[1]); w.y = cvt_pk_bf16(v[2], v[3]); return w; }
__device__ __forceinline__ u32x4 pack8(f32x4 a, f32x4 b) { u32x4 w; w.x = cvt_pk_bf16(a[0], a[1]); w.y = cvt_pk_bf16(a[2], a[3]); w.z = cvt_pk_bf16(b[0], b[1]); w.w = cvt_pk_bf16(b[2], b[3]); return w; }

__device__ __forceinline__ void p0_mod(const float* c, const float* w_ada, const float* b_ada, float* mod, LAS unsigned char* lds, int bid, int nb, int wv_) {
    const int tid = TIDX;
    LAS float* s = (LAS float*)lds;
    LAS float* red = (LAS float*)(lds + 65536);
    for (int i = tid; i < NBATCH * DM; i += NTHREADS) { const float v = c[i]; s[i] = v / (1.0f + __expf(-v)); }
    __syncthreads();
    const int cq = tid % 24, kl = tid / 24;
    for (int chunk = bid; chunk < NMOD / 96; chunk += nb) {
        float acc[4][4];
#pragma unroll
        for (int b = 0; b < 4; ++b)
#pragma unroll
            for (int j = 0; j < 4; ++j) acc[b][j] = 0.f;
        if (tid < 504) {
            const float* wp = w_ada + (size_t)chunk * 96 + cq * 4;
#pragma unroll 8
            for (int k = kl; k < DM; k += 21) {
                const f32x4 w = *(const f32x4*)(wp + (size_t)k * NMOD);
#pragma unroll
                for (int b = 0; b < 4; ++b) { const float sb = s[b * DM + k];
#pragma unroll
                    for (int j = 0; j < 4; ++j) acc[b][j] += sb * w[j]; }
            }
#pragma unroll
            for (int b = 0; b < 4; ++b)
#pragma unroll
                for (int j = 0; j < 4; ++j) red[(kl * 4 + b) * 96 + cq * 4 + j] = acc[b][j];
        }
        __syncthreads();
        if (tid < 384) { const int b = tid / 96, cc = tid % 96; float t = 0.f;
            for (int k = 0; k < 21; ++k) t += red[(k * 4 + b) * 96 + cc];
            mod[(size_t)b * NMOD + chunk * 96 + cc] = t + b_ada[chunk * 96 + cc]; }
        __syncthreads();
    }
}
__device__ __forceinline__ void p0_transpose(const float* src, size_t ldS, unsigned char* dst, size_t ldD, int R, int C, float scale, LAS unsigned char* lds, int bid, int nb, int wv_) {
    const int tid = TIDX; LAS float* tile = (LAS float*)lds;
    const int ntc = C / 64, ntiles = (R / 256) * ntc;
    f32x4 v[8];
#define P0T_LOAD(t_) do { const int tr_ = (t_) / ntc, tc_ = (t_) % ntc; _Pragma("unroll") for (int i = 0; i < 8; ++i) { const int r = (tid >> 4) + 32 * i, c4 = (tid & 15) * 4; \
        v[i] = *(const f32x4*)(src + (size_t)(tr_ * 256 + r) * ldS + tc_ * 64 + c4); } } while (0)
    if (bid < ntiles) P0T_LOAD(bid);
    for (int t = bid; t < ntiles; t += nb) {
        const int tr = t / ntc, tc = t % ntc;
#pragma unroll
        for (int i = 0; i < 8; ++i) { const int r = (tid >> 4) + 32 * i, c4 = (tid & 15) * 4;
#pragma unroll
            for (int j = 0; j < 4; ++j) tile[r * 65 + c4 + j] = v[i][j]; }
        __syncthreads();
        if (t + nb < ntiles) P0T_LOAD(t + nb);
        { const int cc = tid >> 3, r0 = (tid & 7) * 32; u32x2 w[4];
#pragma unroll
            for (int q = 0; q < 4; ++q) { f32x4 a, b;
#pragma unroll
                for (int j = 0; j < 4; ++j) { a[j] = tile[(r0 + q * 8 + j) * 65 + cc] * scale; b[j] = tile[(r0 + q * 8 + 4 + j) * 65 + cc] * scale; }
                w[q] = pack8_fp8(a, b); }
            unsigned char* dp = dst + (size_t)(tc * 64 + cc) * ldD + tr * 256 + r0;
            *(u32x4*)dp = (u32x4){w[0].x, w[0].y, w[1].x, w[1].y}; *(u32x4*)(dp + 16) = (u32x4){w[2].x, w[2].y, w[3].x, w[3].y}; }
        __syncthreads();
    }
#undef P0T_LOAD
}
__device__ __forceinline__ void p0_wc(const float* w_pq, const float* sk1, const float* sk2, bf16_t* wct, LAS unsigned char* lds, int bid, int nb, int wv_) {
    const int tid = TIDX, kk = tid & 63, kg = tid >> 6;
    LAS float* Ws = (LAS float*)lds;
    LAS float* Ss = (LAS float*)(lds + 64 * 132 * 4);
    for (int task = bid; task < 16 * 64; task += nb) {
        const int hh = task >> 6, kc = task & 63; const float* sk = (hh & 1) ? sk2 : sk1;
#pragma unroll
        for (int i = 0; i < 4; ++i) { const int idx = tid + 512 * i, r = idx >> 5, c4 = (idx & 31) * 4;
            *(LAS f32x4*)(Ws + r * 132 + c4) = *(const f32x4*)(w_pq + (size_t)(kc * 64 + r) * (PHEADS * 256) + hh * 128 + c4); }
#pragma unroll
        for (int i = 0; i < 8; ++i) { const int idx = tid + 512 * i, r = idx >> 5, c4 = (idx & 31) * 4;
            *(LAS f32x4*)(Ss + r * 132 + c4) = *(const f32x4*)(sk + (size_t)r * 128 + c4); }
        __syncthreads();
        float acc[4][4];
#pragma unroll
        for (int i = 0; i < 4; ++i)
#pragma unroll
            for (int j = 0; j < 4; ++j) acc[i][j] = 0.f;
        const int tk = tid & 15, tj = tid >> 4;
#pragma unroll 4
        for (int d4 = 0; d4 < 32; ++d4) {
            f32x4 w[4], sv[4];
#pragma unroll
            for (int i = 0; i < 4; ++i) w[i] = *(const LAS f32x4*)(Ws + (tk + 16 * i) * 132 + d4 * 4);
#pragma unroll
            for (int j = 0; j < 4; ++j) sv[j] = *(const LAS f32x4*)(Ss + (4 * tj + j) * 132 + d4 * 4);
#pragma unroll
            for (int i = 0; i < 4; ++i)
#pragma unroll
                for (int j = 0; j < 4; ++j) acc[i][j] += (w[i][0] * sv[j][0] + w[i][1] * sv[j][1]) + (w[i][2] * sv[j][2] + w[i][3] * sv[j][3]);
        }
        __syncthreads();
        { LAS bf16_t* Ot = (LAS bf16_t*)lds;
#pragma unroll
          for (int i = 0; i < 4; ++i)
#pragma unroll
              for (int j = 0; j < 4; ++j) Ot[(4 * tj + j) * 72 + tk + 16 * i] = f2bf(acc[i][j]);
          __syncthreads();
#pragma unroll
          for (int q = 0; q < 2; ++q) { const int P = tid + NTHREADS * q, row = P >> 3, c16 = P & 7;
              *(u32x4*)(wct + (size_t)(hh * 128 + row) * DM + kc * 64 + c16 * 8) = *(const LAS u32x4*)(Ot + row * 72 + c16 * 8); } }
        __syncthreads();
    }
}
__device__ __forceinline__ void p0_prologue(const Args& a, LAS unsigned char* lds, int bid, int nb, int wv_) {
    unsigned char* ws = a.ws; const int tid = TIDX;
    p0_mod(a.in[1], a.in[2], a.in[3], (float*)(ws + WS_MOD), lds, bid, nb, wv_);
    p0_transpose(a.in[5], INC, ws + WS_WINT, DM, DM, NQKV, 64.0f, lds, bid, nb, wv_);
    p0_transpose(a.in[12], DM, ws + WS_WOT, DM, DM, DM, 64.0f, lds, bid, nb, wv_);
    p0_transpose(a.in[18], DM, ws + WS_VT, NEXP, NEXP, DM, 1.0f, lds, bid, nb, wv_);
    p0_wc(a.in[14], a.in[15], a.in[16], (bf16_t*)(ws + WS_WCT), lds, bid, nb, wv_);
    {
        const float* u = a.in[17]; unsigned char* ub = ws + WS_UB; const size_t n8 = (size_t)NEXP * DM / 8;
        const size_t st = (size_t)nb * NTHREADS; size_t i = (size_t)bid * NTHREADS + tid;
        for (; i + 7 * st < n8; i += 8 * st) {
            f32x4 x[16];
#pragma unroll
            for (int q = 0; q < 8; ++q) { x[2 * q] = *(const f32x4*)(u + (i + q * st) * 8); x[2 * q + 1] = *(const f32x4*)(u + (i + q * st) * 8 + 4); }
#pragma unroll
            for (int q = 0; q < 8; ++q) *(u32x2*)(ub + (i + q * st) * 8) = pack8_fp8(x[2 * q] * 64.0f, x[2 * q + 1] * 64.0f); }
        for (; i < n8; i += st) {
            const f32x4 x0 = *(const f32x4*)(u + i * 8), x1 = *(const f32x4*)(u + i * 8 + 4); *(u32x2*)(ub + i * 8) = pack8_fp8(x0 * 64.0f, x1 * 64.0f); }
    }
    {
        const float* w = a.in[5]; bf16_t* wf = (bf16_t*)(ws + WS_WFZT);
        for (int k = bid * NTHREADS + tid; k < DM; k += nb * NTHREADS) {
#pragma unroll
            for (int q = 0; q < 4; ++q) { const f32x4 v = *(const f32x4*)(w + (size_t)k * INC + NQKV + q * 4);
#pragma unroll
                for (int j = 0; j < 4; ++j) wf[(size_t)(q * 4 + j) * DM + k] = f2bf(v[j]); } }
    }
}

template <bool WITH_FZ, bool WITH_F8, bool WITH_BF16, bool WITH_F6 = false, bool IN_BF16 = false>
__device__ __forceinline__ void norm_phase(const void* xin, const float* g, const float* sh, const float* sc, bf16_t* out, unsigned char* out8,
                                           const bf16_t* wfzt, const float* b_f, float* logf, LAS unsigned char* lds, int bid, int nb, int wv_) {
    const int tid = TIDX, wid = wv_, lane = tid & 63;
    constexpr int ROWB = DM * 2 + 16;
    LAS float* red = (LAS float*)(lds + 16 * ROWB);
    using XT = typename pg8::ErVec<IN_BF16>::type;
#define NR_LOAD(BUF, row_) do { _Pragma("unroll") for (int j = 0; j < 16; ++j)                                                                                       \
        BUF[j] = *(const XT*)((const char*)xin + ((size_t)(row_) * DM + j * 256 + lane * 4) * (IN_BF16 ? 2 : 4)); } while (0)
#define NR_ROW(BUF, rr_) do { const int lr = wid * 2 + (rr_);                                                                                                        \
            float ss = 0.f;                                                                                                                                            \
            _Pragma("unroll") for (int j = 0; j < 16; ++j) { const f32x4 v = pg8::er_to4(BUF[j]); ss += (v[0] * v[0] + v[1] * v[1]) + (v[2] * v[2] + v[3] * v[3]); }      \
            ss = wave_sum(ss);                                                                                                                                         \
            const float rinv = __builtin_amdgcn_rsqf(ss * (1.0f / DM) + NORM_EPS);                                                                                     \
            _Pragma("unroll") for (int j = 0; j < 16; ++j) { const int cidx = j * 256 + lane * 4;                                                                      \
                const f32x4 vj = pg8::er_to4(BUF[j]);                                                                                                                 \
                f32x4 pa_, ph_;                                                                                                                                        \
                if constexpr (PBF) { pa_ = pg8::unpack4_bf16(*(const LAS u32x2*)(pb + cidx * 2)); ph_ = pg8::unpack4_bf16(*(const LAS u32x2*)(pb + 8192 + cidx * 2)); }   \
                else { pa_ = *(const LAS f32x4*)(pb + cidx * 4); ph_ = *(const LAS f32x4*)(pb + 16384 + cidx * 4); }                                                    \
                const f32x4 y = (vj * rinv) * pa_ + ph_; const u32x2 w = pack4(y);                                                                                     \
                if constexpr (WITH_BF16) *(u32x2*)(out + (size_t)(r0 + lr) * DM + cidx) = w;                                                                            \
                if constexpr (WITH_F8) { int w8 = __builtin_amdgcn_cvt_pk_fp8_f32(y[0], y[1], 0, false); w8 = __builtin_amdgcn_cvt_pk_fp8_f32(y[2], y[3], w8, true); *(int*)(out8 + (size_t)(r0 + lr) * DM + cidx) = w8; } \
                if constexpr (WITH_FZ) *(LAS u32x2*)(lds + lr * ROWB + cidx * 2) = w;                                                                                   \
                if constexpr (WITH_F6) *(LAS u32x2*)(lds + lr * ROWB + cidx * 2) = pack4(y * 1.6f); } } while (0)
    constexpr bool PBF = WITH_FZ || WITH_F6;
    LAS unsigned char* pb = lds + (PBF ? 16 * ROWB + 8192 : 0);
    XT rowA[16], rowB[16];
    if (bid < NTOK / 16) NR_LOAD(rowA, bid * 16 + wid * 2);
    for (int it = bid; it < NTOK / 16; it += nb) {
        const int r0 = it * 16, b = r0 / SEQ;
        {
            const int c8 = tid * 8;
            const f32x4 g0 = *(const f32x4*)(g + c8), g1 = *(const f32x4*)(g + c8 + 4), s0 = *(const f32x4*)(sc + (size_t)b * NMOD + c8), s1 = *(const f32x4*)(sc + (size_t)b * NMOD + c8 + 4);
            const f32x4 h0 = *(const f32x4*)(sh + (size_t)b * NMOD + c8), h1 = *(const f32x4*)(sh + (size_t)b * NMOD + c8 + 4);
            NR_LOAD(rowB, r0 + wid * 2 + 1);
            __syncthreads();
            { const f32x4 a0 = g0 * (s0 + 1.0f), a1 = g1 * (s1 + 1.0f);
              if constexpr (PBF) { *(LAS u32x4*)(pb + c8 * 2) = pack8(a0, a1); *(LAS u32x4*)(pb + 8192 + c8 * 2) = pack8(h0, h1); }
              else { *(LAS f32x4*)(pb + c8 * 4) = a0; *(LAS f32x4*)(pb + c8 * 4 + 16) = a1; *(LAS f32x4*)(pb + 16384 + c8 * 4) = h0; *(LAS f32x4*)(pb + 16384 + c8 * 4 + 16) = h1; } }
            __syncthreads();
            NR_ROW(rowA, 0);
            if (it + nb < NTOK / 16) NR_LOAD(rowA, (it + nb) * 16 + wid * 2);
            NR_ROW(rowB, 1);
        }
        if constexpr (WITH_F6) {
            __syncthreads();
#pragma unroll
            for (int i = 0; i < 4; ++i) { const int G = tid + NTHREADS * i, row = G >> 7, grp = G & 127;
                u32x16 w;
#pragma unroll
                for (int q = 0; q < 4; ++q) { const u32x4 t = *(const LAS u32x4*)(lds + row * ROWB + grp * 64 + q * 16); w[4 * q] = t[0]; w[4 * q + 1] = t[1]; w[4 * q + 2] = t[2]; w[4 * q + 3] = t[3]; }
                const i32x6 pk = __builtin_amdgcn_cvt_scalef32_pk32_fp6_bf16(__builtin_bit_cast(bf16x32, w), 1.0f);
                store_fp6_slot(out8 + (size_t)(r0 + row) * DM + (grp >> 2) * 128, grp & 3, pk); }
            __syncthreads();
        }
        if constexpr (WITH_FZ) {
            f32x4 acc = {0.f, 0.f, 0.f, 0.f}; const int fr = lane & 15, fq = lane >> 4;
            bf16x8 bfr[16];
#pragma unroll
            for (int ks = 0; ks < 16; ++ks) bfr[ks] = *(const bf16x8*)(wfzt + (size_t)fr * DM + wid * 512 + ks * 32 + fq * 8);
            __syncthreads();
#pragma unroll
            for (int ks = 0; ks < 16; ++ks) { const int k0 = wid * 512 + ks * 32 + fq * 8;
                const bf16x8 af = *(const LAS bf16x8*)(lds + fr * ROWB + k0 * 2);
                acc = __builtin_amdgcn_mfma_f32_16x16x32_bf16(af, bfr[ks], acc, 0, 0, 0); }
#pragma unroll
            for (int j = 0; j < 4; ++j) red[wid * 256 + (fq * 4 + j) * 16 + fr] = acc[j];
            __syncthreads();
            if (tid < 256) { float z = 0.f;
                const int row = tid & 15, n = tid >> 4;
#pragma unroll
                for (int w = 0; w < 8; ++w) z += red[w * 256 + row * 16 + n];
                z += b_f[n];
                const float lf = fminf(z, 0.f) - log1pf(__expf(-fabsf(z)));
                const int tok = r0 + row; logf[((size_t)(tok / SEQ) * NHB + n) * SEQ + (tok % SEQ)] = lf; }
            __syncthreads();
        }
    }
}

#undef NR_LOAD
#undef NR_ROW
__device__ __forceinline__ void cumsum_phase(const float* logf, float* nbias, LAS unsigned char* aux, int bid, int nb, int wv_) {
    const int tid = TIDX, wid = wv_, lane = tid & 63; LAS float* wt = (LAS float*)aux;
    for (int seq = bid; seq < NBATCH * NHB; seq += nb) {
        const float* p = logf + (size_t)seq * SEQ + tid * 8; const f32x4 a = *(const f32x4*)p, b = *(const f32x4*)(p + 4);
        float v[8] = {a[0], a[1], a[2], a[3], b[0], b[1], b[2], b[3]};
#pragma unroll
        for (int j = 1; j < 8; ++j) v[j] += v[j - 1];
        float incl = v[7];
#pragma unroll
        for (int o = 1; o < 64; o <<= 1) { const float t = __shfl_up(incl, o); if (lane >= o) incl += t; }
        if (lane == 63) wt[wid] = incl;
        __syncthreads();
        float off = incl - v[7];
        for (int w = 0; w < wid; ++w) off += wt[w];
        f32x4 o0, o1;
#pragma unroll
        for (int j = 0; j < 4; ++j) { o0[j] = -(v[j] + off) * 11.313708498984761f; o1[j] = -(v[4 + j] + off) * 11.313708498984761f; }
        float* q = nbias + (size_t)seq * SEQ + tid * 8; *(f32x4*)q = o0; *(f32x4*)(q + 4) = o1;
        __syncthreads();
    }
}

namespace att {
constexpr float SCALE = 0.08838834764831845f, C2 = 1.4426950408889634f * SCALE, RSCALE = 11.313708498984761f;
constexpr int TAB_N = 2049;
__device__ __forceinline__ int v_rd_base(int lane) { return ((lane & 3) << 3) | (((lane >> 2) & 3) << 6) | (((lane >> 4) & 1) << 5) | (((lane >> 5) & 1) << 8); }
__device__ __forceinline__ int crow(int r, int hi) { return (r & 3) + 8 * (r >> 2) + 4 * hi; }
__device__ __forceinline__ int t5_bucket(int dist) {
    if (dist < 16) return dist;
    const float v = logf((float)dist * (1.0f / 16.0f)) / 4.852030263919617f * 16.0f;
    int large = 16 + (int)v; return large < 31 ? large : 31;
}

}

#ifndef ATT_PROBE
#define ATT_PROBE 0
#endif
#ifndef FOXDBG
#define FOXDBG 1
#endif
namespace att2 {
using att::crow; using att::t5_bucket; using att::v_rd_base;
constexpr float SCALE = att::SCALE, C2 = att::C2, RSCALE = att::RSCALE; constexpr int TAB_N = att::TAB_N;
#define GLDS16(gptr, ldsptr) __builtin_amdgcn_global_load_lds((const unsigned*)(gptr), (LAS unsigned*)(ldsptr), 16, 0, 0)
#define TABIDX(d) ((int)((d) >> 4) + (int)((d) & 15) * 129)
#define VMW(n) asm volatile("s_waitcnt vmcnt(" #n ")" ::: "memory")
#define BAR_LDS() do { asm volatile("s_waitcnt lgkmcnt(0)" ::: "memory"); __builtin_amdgcn_s_barrier(); asm volatile("" ::: "memory"); } while (0)

template <int NP>
__device__ __forceinline__ void softmax_step(f32x16 (&p)[NP], float& m, float& l, f32x16 (&o)[4], bf16x8 (&pa)[2 * NP], LAS float* xch, int r32, int hi) {
    float pmax = p[0][0];
#pragma unroll
    for (int i = 0; i < NP; ++i)
#pragma unroll
        for (int r = 0; r < 16; ++r) pmax = fmaxf(pmax, p[i][r]);
    { auto rr = __builtin_amdgcn_permlane32_swap(__float_as_uint(pmax), __float_as_uint(pmax), false, false);
      pmax = fmaxf(__uint_as_float(rr[0]), __uint_as_float(rr[1])); }
    const float mn = fmaxf(m, pmax);
    const float alpha = __builtin_amdgcn_exp2f((m - mn) * C2);
    m = mn;
    const float mnL = -mn * C2;
    float ps = 0.f;
#pragma unroll
    for (int i = 0; i < NP; ++i)
#pragma unroll
        for (int r = 0; r < 16; ++r) { p[i][r] = __builtin_amdgcn_exp2f(fmaf(p[i][r], C2, mnL)); ps += p[i][r]; }
    { auto rr = __builtin_amdgcn_permlane32_swap(__float_as_uint(ps), __float_as_uint(ps), false, false);
      ps = __uint_as_float(rr[0]) + __uint_as_float(rr[1]); }
    l = l * alpha + ps;
    if (__any(alpha < 1.f)) {
        if (hi == 0) xch[r32] = alpha;
        asm volatile("s_waitcnt lgkmcnt(0)" ::: "memory");
#pragma unroll
        for (int g = 0; g < 4; ++g) { const f32x4 av = *(const LAS f32x4*)(xch + 8 * g + 4 * hi);
#pragma unroll
            for (int d0 = 0; d0 < 4; ++d0) { o[d0][4 * g + 0] *= av[0]; o[d0][4 * g + 1] *= av[1]; o[d0][4 * g + 2] *= av[2]; o[d0][4 * g + 3] *= av[3]; } }
        asm volatile("" ::: "memory");
    }
#define PK4(P, B_, OUT) do { unsigned a0 = cvt_pk_bf16(P[B_+0], P[B_+1]), a1 = cvt_pk_bf16(P[B_+2], P[B_+3]);                \
        unsigned b0 = cvt_pk_bf16(P[B_+4], P[B_+5]), b1 = cvt_pk_bf16(P[B_+6], P[B_+7]);                                    \
        auto r0 = __builtin_amdgcn_permlane32_swap(a0, b0, false, false); auto r1 = __builtin_amdgcn_permlane32_swap(a1, b1, false, false); \
        u32x4 w = {r0[0], r1[0], r0[1], r1[1]}; OUT = *reinterpret_cast<bf16x8*>(&w); } while (0)
#pragma unroll
    for (int i = 0; i < NP; ++i) { PK4(p[i], 0, pa[2 * i]); PK4(p[i], 8, pa[2 * i + 1]); }
#undef PK4
}
template <int NKS>
__device__ __forceinline__ void pv_step(f32x16 (&o)[4], const bf16x8 (&pa)[NKS], int vb0) {
#define TRRD(dst, off) asm volatile("ds_read_b64_tr_b16 %0, %1 offset:%2" : "=&v"(dst) : "v"(vb0), "i"(off) : "memory")
#define PV_RD(B_, d0) do { TRRD(lo_[B_][0], (d0) * 512); TRRD(hi_[B_][0], (d0) * 512 + 2048); TRRD(lo_[B_][1], (d0) * 512 + 4096); TRRD(hi_[B_][1], (d0) * 512 + 6144);  \
        if constexpr (NKS == 4) { TRRD(lo_[B_][2], (d0) * 512 + 8192); TRRD(hi_[B_][2], (d0) * 512 + 10240); TRRD(lo_[B_][3], (d0) * 512 + 12288); TRRD(hi_[B_][3], (d0) * 512 + 14336); } } while (0)
#define PV_MM(B_, d0) do { _Pragma("unroll") for (int ks = 0; ks < NKS; ++ks)                                                                            \
            o[d0] = __builtin_amdgcn_mfma_f32_32x32x16_bf16(pa[ks], (bf16x8){lo_[B_][ks][0], lo_[B_][ks][1], lo_[B_][ks][2], lo_[B_][ks][3], hi_[B_][ks][0], hi_[B_][ks][1], hi_[B_][ks][2], hi_[B_][ks][3]}, o[d0], 0, 0, 0); } while (0)
#define PV_WAIT(n) do { if constexpr (NKS == 4) { if ((n) != 0) asm volatile("s_waitcnt lgkmcnt(8)" ::: "memory"); else asm volatile("s_waitcnt lgkmcnt(0)" ::: "memory"); }          \
                        else { if ((n) != 0) asm volatile("s_waitcnt lgkmcnt(4)" ::: "memory"); else asm volatile("s_waitcnt lgkmcnt(0)" ::: "memory"); } __builtin_amdgcn_sched_barrier(0); } while (0)
    s16x4 lo_[2][NKS], hi_[2][NKS];
    PV_RD(0, 0);
    PV_RD(1, 1); PV_WAIT(1); PV_MM(0, 0); __builtin_amdgcn_sched_barrier(0);
    PV_RD(0, 2); PV_WAIT(1); PV_MM(1, 1); __builtin_amdgcn_sched_barrier(0);
    PV_RD(1, 3); PV_WAIT(1); PV_MM(0, 2); __builtin_amdgcn_sched_barrier(0);
    PV_WAIT(0); PV_MM(1, 3);
#undef PV_RD
#undef PV_MM
#undef PV_WAIT
#undef TRRD
}
__device__ __forceinline__ void store_o(const f32x16 (&o)[4], float l, unsigned char* mix, size_t tok0, int tstride, int col0, LAS float* xch, int, int) {
    const int lf_ = lane_fresh(), r32 = lf_ & 31, hi = lf_ >> 5;
    asm volatile("" ::: "memory");
    if (hi == 0) xch[32 + r32] = l;
    asm volatile("s_waitcnt lgkmcnt(0)" ::: "memory");
    const int srca = ((4 * (r32 & 7)) + 32 * hi) << 2, dsel = r32 >> 3;
#pragma unroll
    for (int r = 0; r < 16; ++r) { const int rr = crow(r, hi); const float rl = 16.0f * __builtin_amdgcn_rcpf(xch[32 + rr]);
        unsigned char* rowp = mix + (tok0 + (size_t)tstride * rr) * DM + col0;
        int g[4];
#pragma unroll
        for (int d0 = 0; d0 < 4; ++d0) { const float v = o[d0][r] * rl; const float vn = __int_as_float(__builtin_amdgcn_mov_dpp(__float_as_int(v), 0xB1, 0xF, 0xF, true));
            const int pk = __builtin_amdgcn_cvt_pk_fp8_f32(v, vn, 0, false) & 0xffff; const int pk2 = __builtin_amdgcn_mov_dpp(pk, 0x4E, 0xF, 0xF, true);
            g[d0] = __builtin_amdgcn_ds_bpermute(srca, (int)((unsigned)pk | ((unsigned)pk2 << 16))); }
        const int w = dsel == 0 ? g[0] : dsel == 1 ? g[1] : dsel == 2 ? g[2] : g[3];
        *(unsigned*)(rowp + 4 * r32) = (unsigned)w; }
    asm volatile("" ::: "memory");
}

struct CoopSrc { int krow[2], kcol[2], vrow[2], vcol[2]; };
__device__ __forceinline__ void make_ident(bf16x8 (&qb)[2], int l) {
    asm volatile("" : "+v"(l));
    const int r32 = l & 31, j = r32 & 7, on_hi = ((r32 >> 3) & 1) == (l >> 5);
#pragma unroll
    for (int s2 = 0; s2 < 2; ++s2) { const unsigned val = (on_hi && (r32 >> 4) == s2) ? (0x3F80u << (16 * (j & 1))) : 0u; u32x4 w;
#pragma unroll
        for (int k = 0; k < 4; ++k) w[k] = (k == (j >> 1)) ? val : 0u;
        qb[s2] = *reinterpret_cast<bf16x8*>(&w); }
}
template <int MODE>
__device__ __forceinline__ void qk_tile(f32x16 (&p)[2], const bf16x8 (&qr)[8], int tp, int slot, const LAS float* nbl, const int (&kaddr)[4], int hi,
                                        const LAS unsigned char* gtab = nullptr, int nbase = 0, int lane_id = 0, int s2s = 32) {
    if constexpr (MODE == 0) {
#pragma unroll
        for (int g = 0; g < 4; ++g) { const f32x4 b0 = *(const LAS f32x4*)(nbl + tp + 8 * g + 4 * hi), b1 = *(const LAS f32x4*)(nbl + tp + 32 + 8 * g + 4 * hi);
#pragma unroll
            for (int j = 0; j < 4; ++j) { p[0][4 * g + j] = b0[j]; p[1][4 * g + j] = b1[j]; } }
    } else {
#pragma unroll
        for (int r = 0; r < 16; ++r) { p[0][r] = 0.f; p[1][r] = 0.f; }
        bf16x8 qb[2]; make_ident(qb, lane_id);
#pragma unroll
        for (int i = 0; i < 2; ++i)
#pragma unroll
            for (int s2 = 0; s2 < 2; ++s2) { int n0 = nbase + s2s * s2 - 32 * i; n0 = n0 < 0 ? 0 : (n0 > 257 ? 257 : n0);
                const bf16x8 gf = *(const LAS bf16x8*)(gtab + n0 * 16);
                p[i] = __builtin_amdgcn_mfma_f32_32x32x16_bf16(gf, qb[s2], p[i], 0, 0, 0); }
    }
    { int ka_[4];
#pragma unroll
      for (int dd = 0; dd < 4; ++dd) ka_[dd] = kaddr[dd] + slot * 16384;
      bf16x8 kf0[2], kf1[2];
#define QK_RD(B_, d0) do { if ((d0) < 4) { asm volatile("ds_read_b128 %0, %1" : "=&v"(kf0[B_]) : "v"(ka_[(d0) & 3]) : "memory"); asm volatile("ds_read_b128 %0, %1 offset:8192" : "=&v"(kf1[B_]) : "v"(ka_[(d0) & 3]) : "memory"); } \
                           else { asm volatile("ds_read_b128 %0, %1 offset:128" : "=&v"(kf0[B_]) : "v"(ka_[(d0) & 3]) : "memory"); asm volatile("ds_read_b128 %0, %1 offset:8320" : "=&v"(kf1[B_]) : "v"(ka_[(d0) & 3]) : "memory"); } } while (0)
#define QK_MM(B_, d0, n_) do { asm volatile("s_waitcnt lgkmcnt(" #n_ ")" ::: "memory"); __builtin_amdgcn_sched_barrier(0);                                 \
        p[0] = __builtin_amdgcn_mfma_f32_32x32x16_bf16(kf0[B_], qr[d0], p[0], 0, 0, 0); p[1] = __builtin_amdgcn_mfma_f32_32x32x16_bf16(kf1[B_], qr[d0], p[1], 0, 0, 0); __builtin_amdgcn_sched_barrier(0); } while (0)
      QK_RD(0, 0);
      QK_RD(1, 1); QK_MM(0, 0, 2);
      QK_RD(0, 2); QK_MM(1, 1, 2);
      QK_RD(1, 3); QK_MM(0, 2, 2);
      QK_RD(0, 4); QK_MM(1, 3, 2);
      QK_RD(1, 5); QK_MM(0, 4, 2);
      QK_RD(0, 6); QK_MM(1, 5, 2);
      QK_RD(1, 7); QK_MM(0, 6, 2);
      QK_MM(1, 7, 0);
#undef QK_RD
#undef QK_MM
    }
}
template <int MODE>
__device__ __forceinline__ void sm_tile(f32x16 (&p)[2], bf16x8 (&pa)[4], f32x16 (&o)[4], float& m, float& l, int tp, int qpos, int qlo, unsigned wq, const LAS float* tab, LAS float* xch, int r32, int hi) {
    const float NEG = -__builtin_inff(); const int dq = qpos - tp - 4 * hi;
    if constexpr (MODE == 0) {
        if (tp + 63 > qlo) {
#pragma unroll
            for (int r = 0; r < 16; ++r) { const int c = (r & 3) + 8 * (r >> 2); if (c > dq) p[0][r] = NEG; if (c + 32 > dq) p[1][r] = NEG; }
        }
    } else {
        if (tp < 0) {
#pragma unroll
            for (int r = 0; r < 16; ++r) { const int kp = tp + 4 * hi + (r & 3) + 8 * (r >> 2); if (kp < 0) p[0][r] = NEG; if (kp + 32 < 0) p[1][r] = NEG; }
        }
    }
    softmax_step<2>(p, m, l, o, pa, xch, r32, hi);
}
template <int MODE>
__device__ __forceinline__ void coop_tiles(f32x16 (&o)[4], float& m, float& l, bf16x8 (&qr)[8], const bf16_t* Kp, const bf16_t* Vp, int t_first, int n_t, int dir, int pos0, int qpos, int qlo, unsigned wq,
                                           const LAS float* nbl, const LAS float* tab, LAS unsigned char* kbuf, LAS unsigned char* vbuf, const int (&kaddr)[4], int vb00, const CoopSrc& cs,
                                           LAS float* xch, int wid, int r32, int hi, const LAS unsigned char* gtab = nullptr, int nb0 = 0, int t_lo = 0, int t_hi = 1 << 30, int dbg = 0, float bqw = 3e30f) {
#define ISSUE_T(t_, slot_) do { const int lf_ = lane_fresh();           \
        _Pragma("unroll") for (int i = 0; i < 2; ++i) { const int P_ = (2 * wid + i) * 64 + lf_;                                              \
        const int krow_ = P_ >> 4, kcol_ = ((P_ & 15) ^ (krow_ & 7)) * 8;                                                                     \
        const int sb_ = P_ >> 5, kk_ = (sb_ >> 2) * 8 + ((P_ >> 2) & 7), vrow_ = (kk_ & ~0xC) | ((kk_ & 4) << 1) | ((kk_ & 8) >> 1), vcol_ = (sb_ & 3) * 32 + (P_ & 3) * 8; \
        int kp_ = pos0 + 64 * (t_) + krow_; kp_ = kp_ < 0 ? 0 : (kp_ > SEQ - 1 ? SEQ - 1 : kp_);                                              \
        int vp_ = pos0 + 64 * (t_) + vrow_; vp_ = vp_ < 0 ? 0 : (vp_ > SEQ - 1 ? SEQ - 1 : vp_);                                              \
        GLDS16(Kp + (size_t)kp_ * HD + kcol_, kbuf + (slot_) * 16384 + (2 * wid + i) * 1024);                                                 \
        GLDS16(Vp + (size_t)vp_ * HD + vcol_, vbuf + (slot_) * 16384 + (2 * wid + i) * 1024); } } while (0)
    int t_act = 1 << 30;
    if (MODE == 0) t_act = ((qlo + 31 - pos0) >> 6) + 1;
    const bool late = wid >= 4;
    ISSUE_T(t_first, 0);
    if (n_t > 1) ISSUE_T(t_first + dir, 1);
#pragma unroll
    for (int d0 = 0; d0 < 8; ++d0) asm volatile("" : "+v"(qr[d0]));
#define WSTOP(tp_) do { if (MODE == 0 && dir < 0 && (tp_) > 0) wdone = __all(bqw + nbl[(tp_) - 1] < m - 40.0f / C2); } while (0)
    bool wdone = false;
    bf16x8 pa[4]; f32x16 p[2]; int sl = 0; bool prev_on = false; int tp_prev = 0;
    for (int k = 0, t = t_first; k < n_t; ++k, t += dir, sl = (sl + 1) & 3) {
        if (k + 1 < n_t) VMW(4); else VMW(0);
        BAR_LDS();
        if (k + 2 < n_t) ISSUE_T(t + 2 * dir, (sl + 2) & 3);
        if (prev_on) {
            if (late) { sm_tile<MODE>(p, pa, o, m, l, tp_prev, qpos, qlo, wq, tab, xch, r32, hi); WSTOP(tp_prev); }
            pv_step<4>(o, pa, vb00 + ((sl + 3) & 3) * 16384);
        }
        const bool on = MODE == 0 ? (t < t_act && !wdone) : (t >= t_lo && t <= t_hi);
        if (on) {
            const int tp = pos0 + 64 * t;
            qk_tile<MODE>(p, qr, tp, sl, nbl, kaddr, hi, gtab, nb0 - 64 * t, r32 + 32 * hi);
            if (!late) { sm_tile<MODE>(p, pa, o, m, l, tp, qpos, qlo, wq, tab, xch, r32, hi); WSTOP(tp); }
            tp_prev = tp;
        }
        prev_on = on;
    }
    if (prev_on) {
        if (late) sm_tile<MODE>(p, pa, o, m, l, tp_prev, qpos, qlo, wq, tab, xch, r32, hi);
        pv_step<4>(o, pa, vb00 + ((sl + 3) & 3) * 16384);
    }
#undef ISSUE_T
#undef WSTOP
}
__device__ __forceinline__ void coop_setup(CoopSrc& cs, int (&kaddr)[4], LAS unsigned char* kbuf, int wid, int lane, int r32, int hi) {
#pragma unroll
    for (int dd = 0; dd < 4; ++dd) kaddr[dd] = (int)(uintptr_t)kbuf + r32 * 256 + (((2 * dd + hi) ^ (r32 & 7)) << 4);
#pragma unroll
    for (int i = 0; i < 2; ++i) { const int P = (2 * wid + i) * 64 + lane;
        { const int row = P >> 4, c = (P & 15) ^ (row & 7); cs.krow[i] = row; cs.kcol[i] = c * 8; }
        { const int sb = P >> 5, k7 = (P >> 2) & 7, cc = P & 3, kk = (sb >> 2) * 8 + k7, k = (kk & ~0xC) | ((kk & 4) << 1) | ((kk & 8) >> 1); cs.vrow[i] = k; cs.vcol[i] = (sb & 3) * 32 + cc * 8; } }
}

__device__ __forceinline__ void build_gtab(const float* rel_bias, bf16_t* tab, int bid, int nb, int wv_) {
    for (int i = bid * NTHREADS + wv_ * 64 + lane_fresh(); i < NHA * 3 * 258 * 8; i += nb * NTHREADS) {
        const int h = i / (3 * 258 * 8), r = i % (3 * 258 * 8), j = r & 7, e = r >> 3, br = e / 258, n0 = e % 258 - 128;
        const int nn = n0 + j * (br == 0 ? 1 : (16 >> (2 * br)));
        const float v = (nn >= 0 && nn <= 128) ? rel_bias[t5_bucket(nn << (2 * br)) * NHA + h] * RSCALE : -3e30f;
        tab[i] = f2bf(v); }
}
__device__ __forceinline__ void dilated_part(const bf16_t* qkv, const float* rel_bias, unsigned char* mix, LAS unsigned char* lds, int bid, int nb, int wv_) {
    const int wid = wv_; int r32, hi; { const int lf_ = lane_fresh(); r32 = lf_ & 31; hi = lf_ >> 5; }
    LAS unsigned char* kl = lds + wid * 16384;
    LAS unsigned char* kbuf = lds; LAS unsigned char* vbuf = lds + 65536;
    LAS unsigned char* gtab = lds + 131072;
    LAS float* xch = (LAS float*)(lds + 147456) + wid * 64;
    for (int item = bid; item < NBATCH * NHA * 4; item += nb) {
        const int xj = item & 7, xk = item >> 3;
        for (int j4 = 0; j4 < 4; ++j4) {
        const int bh = (xj * 8 + 2 * j4 + (xk >> 4)) & 63, b = bh >> 4, h = bh & 15;
        __syncthreads();
        { const int tg_ = wid * 64 + lane_fresh();
          for (int i = tg_; i < 3 * 258; i += NTHREADS) *(LAS u32x4*)(gtab + i * 16) = *(const u32x4*)((const unsigned char*)rel_bias + (size_t)h * (3 * 258 * 16) + i * 16); }
        const size_t boff = (size_t)b * SEQ;
        const bf16_t* Qp = qkv + ((size_t)(0 + h) * NTOK + boff) * HD; const bf16_t* Kp = qkv + ((size_t)(16 + h) * NTOK + boff) * HD; const bf16_t* Vp = qkv + ((size_t)(32 + h) * NTOK + boff) * HD;
        {
            const int cg = xk & 15, T0 = 8 * (cg & 1) + 512 * (cg >> 1), t0 = T0 + wid;
            bf16x8 qr[8]; f32x16 o[4]; float m = -1e30f, l = 0.f;
            { int lr_ = lane_fresh();
              const int nq = lr_ & 31, qposA = T0 + 64 * wid + 16 * (nq >> 3) + (nq & 7);
#pragma unroll
              for (int d0 = 0; d0 < 8; ++d0) qr[d0] = *(const bf16x8*)(Qp + (size_t)qposA * HD + d0 * 16 + (lr_ >> 5) * 8); }
#pragma unroll
            for (int d0 = 0; d0 < 4; ++d0)
#pragma unroll
                for (int r = 0; r < 16; ++r) o[d0][r] = 0.f;
            __syncthreads();
            { int lo_ = lane_fresh();
              const int r32o = lo_ & 31, hio = lo_ >> 5; int caddr[4]; CoopSrc cs; coop_setup(cs, caddr, kbuf, wid, lo_, r32o, hio);
              const int vb00 = (int)(uintptr_t)vbuf + v_rd_base(lo_);
              const int pos0 = T0 - 128, ts = pos0 < 0 ? ((-pos0) >> 6) : 0;
              coop_tiles<1>(o, m, l, qr, Kp, Vp, ts, 10 - ts, 1, pos0, 0, 0, 0u, nullptr, nullptr, kbuf, vbuf, caddr, vb00, cs, xch, wid, r32, hi, gtab, 64 * wid + 16 * hio + 256 - r32o, wid, wid + 2); }
            __syncthreads();
            const int qpos = t0 + 16 * r32;
            { int lh_ = lane_fresh();
              const int nh = lh_ & 31, hh_ = lh_ >> 5;
#pragma unroll
              for (int d0 = 0; d0 < 8; ++d0) qr[d0] = *(const bf16x8*)(Qp + (size_t)(t0 + 16 * nh) * HD + d0 * 16 + hh_ * 8);
              { LAS float* ob = (LAS float*)lds + 32 * wid * 128 + nh;
#pragma unroll
                for (int d0 = 0; d0 < 4; ++d0)
#pragma unroll
                    for (int r = 0; r < 16; ++r) ob[crow(r, hh_) * 128 + 32 * d0] = o[d0][r];
                if (hh_ == 0) { LAS float* ml = (LAS float*)(lds + 147456); ml[32 * wid + nh] = m; ml[256 + 32 * wid + nh] = l; } }
              __syncthreads();
              { const LAS float* ob = (const LAS float*)lds + wid * 128 + nh;
#pragma unroll
                for (int d0 = 0; d0 < 4; ++d0)
#pragma unroll
                    for (int r = 0; r < 16; ++r) o[d0][r] = ob[8 * crow(r, hh_) * 128 + 32 * d0];
                const LAS float* ml = (const LAS float*)(lds + 147456); m = ml[8 * nh + wid]; l = ml[256 + 8 * nh + wid]; }
#pragma unroll
              for (int d0 = 0; d0 < 8; ++d0) asm volatile("" : "+v"(qr[d0])); }
            __syncthreads();
            {
                const int cls = wid & 3, hh = wid >> 2, kmc = T0 + cls - 512;
                int ts8 = 0; while (ts8 < 3 && T0 + 3 - 512 + 4 * (64 * ts8 + 63) < 0) ++ts8;
                LAS unsigned char* ktl = lds + cls * 16384; LAS unsigned char* vtl = lds + 65536 + cls * 16384;
                int kaddr4[4]; int vb4, nb4;
                { const int lq_ = lane_fresh();
#pragma unroll
                  for (int dd = 0; dd < 4; ++dd) kaddr4[dd] = (int)(uintptr_t)ktl + (lq_ & 31) * 256 + (((2 * dd + (lq_ >> 5)) ^ (lq_ & 7)) << 4);
                  vb4 = (int)(uintptr_t)vtl + v_rd_base(lq_);
                  nb4 = 256 + hh + 32 * (lq_ >> 5) - (lq_ & 31); }
#define ISSUE8K(s_) do { const int l4_ = lane_fresh(); _Pragma("unroll") for (int j = 0; j < 16; ++j) { const int P_ = j * 64 + l4_, row_ = P_ >> 4, col_ = ((P_ & 15) ^ (row_ & 7)) * 8;     \
                    int kp_ = kmc + 4 * (64 * (s_) + row_); kp_ = kp_ < 0 ? 0 : (kp_ > SEQ - 1 ? SEQ - 1 : kp_);                                                       \
                    GLDS16(Kp + (size_t)kp_ * HD + col_, ktl + j * 1024); } } while (0)
#define ISSUE8V(s_) do { const int l4_ = lane_fresh(); _Pragma("unroll") for (int j = 0; j < 16; ++j) { const int P_ = j * 64 + l4_, sb_ = P_ >> 5, kk_ = (sb_ >> 2) * 8 + ((P_ >> 2) & 7);      \
                    const int vrow_ = (kk_ & ~0xC) | ((kk_ & 4) << 1) | ((kk_ & 8) >> 1), vcol_ = (sb_ & 3) * 32 + (P_ & 3) * 8;                                         \
                    int kp_ = kmc + 4 * (64 * (s_) + vrow_); kp_ = kp_ < 0 ? 0 : (kp_ > SEQ - 1 ? SEQ - 1 : kp_);                                                      \
                    GLDS16(Vp + (size_t)kp_ * HD + vcol_, vtl + j * 1024); } } while (0)
                if (hh == 0) ISSUE8K(ts8); else ISSUE8V(ts8);
                for (int s8 = ts8; s8 < 4; ++s8) {
                    if (hh == 0) VMW(0);
                    BAR_LDS();
                    if (hh != 0 && s8 > ts8) ISSUE8V(s8);
                    f32x16 p[2];
                    qk_tile<1>(p, qr, 0, 0, nullptr, kaddr4, hi, gtab + 258 * 16, nb4 - 64 * s8, r32 + 32 * hi, 64);
                    BAR_LDS();
                    if (hh == 0 && s8 + 1 < 4) ISSUE8K(s8 + 1);
                    { const int kp0 = kmc + 256 * s8;
                      if (kp0 < 0) { const float NEG = -__builtin_inff();
#pragma unroll
                          for (int r = 0; r < 16; ++r) { const int kr = kp0 + 4 * (4 * hi + (r & 3) + 8 * (r >> 2)); if (kr < 0) p[0][r] = NEG; if (kr + 128 < 0) p[1][r] = NEG; } } }
                    bf16x8 pa[4];
                    softmax_step<2>(p, m, l, o, pa, xch, r32, hi);
                    if (hh != 0) VMW(0);
                    BAR_LDS();
                    pv_step<4>(o, pa, vb4);
                }
#undef ISSUE8K
#undef ISSUE8V
            }
            __syncthreads();
            {
            int lp_ = lane_fresh();
            const int vb0 = (int)(uintptr_t)kl + v_rd_base(lp_);
            const int kk7 = (lp_ >> 2) & 7, vk0 = (kk7 & 3) + 8 * (kk7 >> 2), vc0 = (lp_ >> 5) * 32 + (lp_ & 3) * 8;
            const int kr32 = lp_ & 31, khi8 = (lp_ >> 5) * 8;
#define BR_KMIN(b_) (t0 - (128 << (2 * (b_))))
#define BR_NT(b_) ((b_) == 1 ? 8 : 5)
#define BR_TS(b_) (BR_KMIN(b_) < 0 ? ((-BR_KMIN(b_)) >> (5 + 2 * (b_))) : 0)
#define LOAD_K(KF, b_, t_) do { int kp_ = BR_KMIN(b_) + ((32 * (t_) + kr32) << (2 * (b_))); kp_ = kp_ < 0 ? 0 : (kp_ > SEQ - 1 ? SEQ - 1 : kp_);          \
                const bf16_t* kr_ = Kp + (size_t)kp_ * HD + khi8; _Pragma("unroll") for (int d0 = 0; d0 < 8; ++d0) KF[d0] = *(const bf16x8*)(kr_ + d0 * 16); } while (0)
#define ISSUE_V(b_, t_, slot_) do { const int km_ = BR_KMIN(b_), ds_ = 2 * (b_); _Pragma("unroll") for (int j = 0; j < 8; ++j) {                       \
                int kp_ = km_ + ((32 * (t_) + vk0 + 4 * ((j >> 1) & 1) + 16 * (j >> 2)) << ds_); kp_ = kp_ < 0 ? 0 : (kp_ > SEQ - 1 ? SEQ - 1 : kp_);   \
                GLDS16(Vp + (size_t)kp_ * HD + vc0 + 64 * (j & 1), kl + (slot_) * 8192 + j * 1024); } } while (0)
#define PSTEP(KC, KN, vs_) do {                                                                                                                          \
                int nb_ = cb, ntl = ct + 1; has_next = true;                                                                                              \
                if (ntl >= BR_NT(cb)) { nb_ = cb + 1; if (nb_ > 2) has_next = false; else ntl = BR_TS(nb_); }                                             \
                if (has_next) { LOAD_K(KN, nb_, ntl); ISSUE_V(nb_, ntl, 1 - (vs_)); VMW(16); } else VMW(0);                                               \
                f32x16 p[1];                                                                                                                              \
                _Pragma("unroll") for (int r = 0; r < 16; ++r) p[0][r] = 0.f;                                                                             \
                { const int qs_ = 16 >> (2 * cb);                                                     \
                  bf16x8 qbp[2]; make_ident(qbp, lane_fresh());                                                                                                   \
                  int lz_ = lane_fresh();                                                                                             \
                  _Pragma("unroll") for (int s2 = 0; s2 < 2; ++s2) { int n0 = 256 + qs_ * (16 * s2 + 8 * (lz_ >> 5)) - (32 * ct + (lz_ & 31)); n0 = n0 < 0 ? 0 : (n0 > 257 ? 257 : n0); \
                      const bf16x8 gf = *(const LAS bf16x8*)(gtab + (cb * 258 + n0) * 16);                                                                  \
                      p[0] = __builtin_amdgcn_mfma_f32_32x32x16_bf16(gf, qbp[s2], p[0], 0, 0, 0); } }                                                       \
                _Pragma("unroll") for (int d0 = 0; d0 < 8; ++d0) p[0] = __builtin_amdgcn_mfma_f32_32x32x16_bf16(KC[d0], qr[d0], p[0], 0, 0, 0);           \
                { const int kp0 = BR_KMIN(cb) + ((32 * ct) << (2 * cb));                                                                                   \
                  if (kp0 < 0) { const float NEG = -__builtin_inff();                                                                                      \
                      _Pragma("unroll") for (int r = 0; r < 16; ++r) if (kp0 + ((4 * hi + (r & 3) + 8 * (r >> 2)) << (2 * cb)) < 0) p[0][r] = NEG; } }     \
                bf16x8 pa[2];                                                                                                                             \
                softmax_step<1>(p, m, l, o, pa, xch, r32, hi);                                                                                            \
                pv_step<2>(o, pa, vb0 + (vs_) * 8192);                                                                                                    \
                cb = nb_; ct = ntl; } while (0)
            int cb = 2, ct = BR_TS(2); bool has_next = true;
            bf16x8 kfA[8], kfB[8];
            LOAD_K(kfA, cb, ct); ISSUE_V(cb, ct, 0);
            for (;;) {
                PSTEP(kfA, kfB, 0); if (!has_next) break;
                PSTEP(kfB, kfA, 1); if (!has_next) break;
            }
#undef PSTEP
#undef LOAD_K
#undef ISSUE_V
#undef BR_KMIN
#undef BR_NT
#undef BR_TS
            }
            store_o(o, l, mix, boff + t0, 16, h * HD, xch, r32, hi);
        }
        }
    }
}

__device__ __forceinline__ void fox_part(const bf16_t* qkv, const float* nbias, const float* gq, const float* gk, unsigned char* mix, LAS unsigned char* lds, int bid, int nb, int wv_, int dbg = 0) {
    const int wid = wv_; int r32, hi; { const int lf_ = lane_fresh(); r32 = lf_ & 31; hi = lf_ >> 5; }
    asm volatile("" : "+s"(gq), "+s"(gk), "+s"(nbias));
    float bq;
    { const int lb_ = lane_fresh(); float a = fmaxf(fabsf(gq[lb_]), fabsf(gq[lb_ + 64])), c = fmaxf(fabsf(gk[lb_]), fabsf(gk[lb_ + 64]));
#pragma unroll
      for (int o_ = 32; o_ >= 1; o_ >>= 1) { a = fmaxf(a, __shfl_xor(a, o_)); c = fmaxf(c, __shfl_xor(c, o_)); }
      bq = 128.0f * 1.02f * a * c; }
    LAS unsigned char* kbuf = lds;
    LAS unsigned char* vbuf = lds + 65536;
    LAS float* nbl = (LAS float*)(lds + 131072);
    LAS float* xch = (LAS float*)(lds + 147456) + wid * 64;
    for (int item = bid; item < NBATCH * NHB * 8; item += nb) {
        const int xj = item & 7, xk = item >> 3, bh = (xj * 8 + (xk >> 3)) & 63, x = (xk & 32) ? 7 - (xk & 7) : (xk & 7), b = bh >> 4, h = bh & 15;
        const size_t boff = (size_t)b * SEQ;
        const bf16_t* Qp = qkv + ((size_t)(48 + h) * NTOK + boff) * HD; const bf16_t* Kp = qkv + ((size_t)(64 + h) * NTOK + boff) * HD; const bf16_t* Vp = qkv + ((size_t)(80 + h) * NTOK + boff) * HD;
        __syncthreads();
        { int ti_ = wid * 64 + lane_fresh();
          const f32x4 n0_ = *(const f32x4*)(nbias + (size_t)bh * SEQ + ti_ * 4), n1_ = *(const f32x4*)(nbias + (size_t)bh * SEQ + (ti_ + NTHREADS) * 4);
          *(LAS f32x4*)(nbl + ti_ * 4) = n0_; *(LAS f32x4*)(nbl + (ti_ + NTHREADS) * 4) = n1_; }
        for (int half = 0; half < 2; ++half) {
            const int qb = half ? 15 - x : x, NT = 4 * (qb + 1), qlo = qb * 256 + wid * 32, qpos = qlo + r32;
            bf16x8 qr[8];
#pragma unroll
            for (int d0 = 0; d0 < 8; ++d0) qr[d0] = *(const bf16x8*)(Qp + (size_t)qpos * HD + d0 * 16 + hi * 8);
            f32x16 o[4]; float m = -1e30f, l = 0.f;
#pragma unroll
            for (int d0 = 0; d0 < 4; ++d0)
#pragma unroll
                for (int r = 0; r < 16; ++r) o[d0][r] = 0.f;
            __syncthreads();
            int lo_ = lane_fresh();
            int kaddr[4]; CoopSrc cs; coop_setup(cs, kaddr, kbuf, wid, lo_, lo_ & 31, lo_ >> 5);
            const int vb00 = (int)(uintptr_t)vbuf + v_rd_base(lo_);
            int t_stop;
            { const float thr = nbl[qb * 256] - 40.0f / C2 - 2.0f * bq; const int tt = lane_fresh(); const bool sk = tt < NT && nbl[64 * tt + 63] < thr;
              t_stop = __builtin_popcountll(__ballot(sk)); if (t_stop > NT - 1) t_stop = NT - 1; }
            coop_tiles<0>(o, m, l, qr, Kp, Vp, NT - 1, NT - t_stop, -1, 0, qpos, qlo, 0u, nbl, nullptr, kbuf, vbuf, kaddr, vb00, cs, xch, wid, r32, hi, nullptr, 0, 0, 1 << 30, dbg, bq);
            store_o(o, l, mix, boff + qb * 256 + wid * 32, 1, (NHA + h) * HD, xch, r32, hi);
        }
    }
}
__device__ __forceinline__ void attn_phase(const bf16_t* qkv, const float* nbias, const float* rel_bias, const float* gq, const float* gk, unsigned char* mix, LAS unsigned char* lds, int bid, int nb, int wv_) {
    dilated_part(qkv, rel_bias, mix, lds, bid, nb, wv_);
    __syncthreads();
    fox_part(qkv, nbias, gq, gk, mix, lds, bid, nb, wv_);
#if ATT_PROBE == 2
    __syncthreads();
    fox_part(qkv, nbias, gq, gk, mix, lds, bid, nb, wv_);
#endif

}
#undef GLDS16
#undef TABIDX
#undef VMW
#undef BAR_LDS
}

namespace peer {
__device__ __forceinline__ void ins16(float (&L)[16], float x) {
#pragma unroll
    for (int k = 15; k >= 1; --k) L[k] = __builtin_amdgcn_fmed3f(L[k - 1], L[k], x);
    L[0] = fmaxf(L[0], x);
}
__device__ __forceinline__ void top16_stream(const float* base, int lane, float (&L)[16]) {
    const float NEG = -__builtin_inff();
#pragma unroll
    for (int k = 0; k < 16; ++k) L[k] = NEG;
#define TK_LOAD(X, j0_) do { _Pragma("unroll") for (int j = 0; j < 16; ++j) X[j] = base[(size_t)((j0_) + j) * 64 + lane]; } while (0)
#define TK_INS(X, j0_) do { _Pragma("unroll") for (int j = 0; j < 16; ++j) ins16(L, __uint_as_float((__float_as_uint(X[j]) & ~127u) | (unsigned)(127 - ((j0_) + j)))); } while (0)
    float xa[16], xb[16];
    TK_LOAD(xa, 0);
    for (int j0 = 0; j0 < 128; j0 += 32) {
        TK_LOAD(xb, j0 + 16);
        TK_INS(xa, j0);
        if (j0 + 32 < 128) TK_LOAD(xa, j0 + 32);
        TK_INS(xb, j0 + 16);
    }
#undef TK_LOAD
#undef TK_INS
}
__device__ __forceinline__ void topk_phase(const float* sct, unsigned char* gd, float* gatec, int* ec, LAS unsigned char* lds, int bid, int nb, int wv_) {
    const int tid = TIDX, wid = wv_, lane = tid & 63;
    LAS int* ent_e = (LAS int*)lds; LAS float* ent_g = (LAS float*)(lds + 64 * 129 * 4);
#pragma unroll
    for (int k = 0; k < 8; ++k) ((LAS unsigned*)(lds + 74240))[wid * 512 + k * 64 + lane] = 0u;
    for (int tile = bid; tile < NTOK / 64; tile += nb) {
        float L1[16], L2[16];
        top16_stream(sct + (size_t)((wid * 2 + 0) * 256 + tile) * 128 * 64, lane, L1);
        top16_stream(sct + (size_t)((wid * 2 + 1) * 256 + tile) * 128 * 64, lane, L2);
        LAS unsigned char* ix1 = lds + 90624 + tid; LAS unsigned char* ix2 = ix1 + 8192;
#pragma unroll
        for (int k = 0; k < 16; ++k) { ix1[k * 512] = (unsigned char)(127u - (__float_as_uint(L1[k]) & 127u)); ix2[k * 512] = (unsigned char)(127u - (__float_as_uint(L2[k]) & 127u)); }
        float Cv[16];
#pragma unroll
        for (int k = 0; k < 16; ++k) Cv[k] = -__builtin_inff();
#pragma unroll
        for (int i = 0; i < 16; ++i)
#pragma unroll
            for (int j = 0; j < 16; ++j) if ((i + 1) * (j + 1) <= 16)
                ins16(Cv, __uint_as_float((__float_as_uint(L1[i] + L2[j]) & ~255u) | (unsigned)(16 * i + j)));
        int Ce[16];
#pragma unroll
        for (int k = 0; k < 16; ++k) { const unsigned id = __float_as_uint(Cv[k]) & 255u; Ce[k] = (int)ix1[(id >> 4) * 512] * NKEYS + (int)ix2[(id & 15u) * 512]; }
        float ex[16], den = 0.f;
#pragma unroll
        for (int k = 0; k < 16; ++k) { ex[k] = __expf(Cv[k] - Cv[0]); den += ex[k]; }
        const float rden = 1.0f / den;
#pragma unroll
        for (int k = 0; k < 16; ++k) { ent_e[lane * 129 + wid * 16 + k] = Ce[k]; ent_g[lane * 129 + wid * 16 + k] = ex[k] * rden; }
        __syncthreads();
        LAS unsigned char* own = lds + 66048;
        LAS unsigned* bm = (LAS unsigned*)(lds + 74240) + wid * 512;
        for (int tt = 0; tt < 8; ++tt) {
            const int tl = wid * 8 + tt; const LAS int* ee = ent_e + tl * 129; const LAS float* gg = ent_g + tl * 129;
            const int ea = ee[lane], eb = ee[lane + 64]; float ga = 0.f, gb = 0.f; bool oa = true, ob = true;
            const unsigned fa = __hip_atomic_fetch_or(bm + (ea >> 5), 1u << (ea & 31), __ATOMIC_RELAXED, __HIP_MEMORY_SCOPE_WORKGROUP);
            const unsigned fb = __hip_atomic_fetch_or(bm + (eb >> 5), 1u << (eb & 31), __ATOMIC_RELAXED, __HIP_MEMORY_SCOPE_WORKGROUP);
            const bool dup = (((fa >> (ea & 31)) | (fb >> (eb & 31))) & 1u) != 0u;
            asm volatile("s_waitcnt lgkmcnt(0)" ::: "memory");
            bm[ea >> 5] = 0u; bm[eb >> 5] = 0u;
            if (!__any(dup)) { ga = gg[lane]; gb = gg[lane + 64]; }
            else
            for (int j = 0; j < 128; ++j) { const int ej = ee[j]; const float gj = gg[j];
                if (ej == ea) { if (j < lane) oa = false; ga += gj; }
                if (ej == eb) { if (j < lane + 64) ob = false; gb += gj; } }
            const size_t trow = (size_t)(tile * 64 + tl);
            own[tl * 128 + lane] = oa ? (unsigned char)(lane + 1) : (unsigned char)0;
            own[tl * 128 + lane + 64] = ob ? (unsigned char)(lane + 65) : (unsigned char)0;
            gatec[trow * 128 + lane] = oa ? ga : 0.f; gatec[trow * 128 + lane + 64] = ob ? gb : 0.f;
            ec[trow * 128 + lane] = ea; ec[trow * 128 + lane + 64] = eb;
        }
        __syncthreads();
        { LAS unsigned char* img = lds + 90624; const int pm = tile >> 2, q4 = tile & 3, ai = q4 >> 1, wr = q4 & 1;
#pragma unroll
          for (int i = 0; i < 8; ++i) *(LAS u32x4*)(img + (tid + NTHREADS * i) * 16) = (u32x4){0u, 0u, 0u, 0u};
          __syncthreads();
          int epk[16];
#pragma unroll
          for (int k2 = 0; k2 < 16; ++k2) { const int idx = tid + NTHREADS * k2, tl = idx >> 7, sl = idx & 127; const unsigned b = own[idx]; const int e = ent_e[tl * 129 + sl];
              const int pnl = (e >> 8) & 3, col = e & 255, m = (tl >> 4) & 3, fr = tl & 15;
              const int off = ((((pnl * 4 + m) * 2 + (col >> 7)) * 4 + ((col >> 5) & 3)) << 9) + fr * 32 + (col & 31);
              epk[k2] = b != 0u ? (((e >> 10) << 24) | (off << 8) | (int)b) : -1; }
          for (int p = 0; p < 16; ++p) {
#pragma unroll
              for (int k2 = 0; k2 < 16; ++k2) if ((epk[k2] >> 24) == p) img[(epk[k2] >> 8) & 0xffff] = (unsigned char)(epk[k2] & 0xff);
              __syncthreads();
#pragma unroll
              for (int i = 0; i < 8; ++i) { const int P = tid + NTHREADS * i, c = P >> 5, wc = c & 3, bj = (c >> 2) & 1, m = (c >> 3) & 3, pnl = c >> 5;
                  unsigned char* dst = gd + (size_t)(pm * 64 + 4 * p + pnl) * 65536 + (size_t)(((ai * 4 + m) * 2 + bj) * 4096 + (wr * 4 + wc) * 512 + (P & 31) * 16);
                  *(u32x4*)dst = *(const LAS u32x4*)(img + P * 16); *(LAS u32x4*)(img + P * 16) = (u32x4){0u, 0u, 0u, 0u}; }
              __syncthreads();
          } }
    }
}
__device__ __forceinline__ void act_phase(const float* pre, const float* gatec, const int* ec, unsigned char* gd, int bid, int nb, int wv_) {
    const size_t st = (size_t)nb * NTHREADS, n = (size_t)NTOK * 128; size_t i = (size_t)bid * NTHREADS + TIDX;
    for (; i + 7 * st < n; i += 8 * st) {
        float gt[8], pr[8]; int ee[8];
#pragma unroll
        for (int q = 0; q < 8; ++q) { gt[q] = gatec[i + q * st]; pr[q] = pre[i + q * st]; ee[q] = ec[i + q * st]; }
#pragma unroll
        for (int q = 0; q < 8; ++q) if (gt[q] != 0.f) { const float a = pg8::gelu1(pr[q]) * gt[q] * 16.0f;
            gd[pg8::gd_off((int)((i + q * st) >> 7), ee[q])] = (unsigned char)(__builtin_amdgcn_cvt_pk_fp8_f32(a, 0.f, 0, false) & 0xff); }
    }
    for (; i < n; i += st) {
        const float gt = gatec[i];
        if (gt != 0.f) { const float a = pg8::gelu1(pre[i]) * gt * 16.0f;
            gd[pg8::gd_off((int)(i >> 7), ec[i])] = (unsigned char)(__builtin_amdgcn_cvt_pk_fp8_f32(a, 0.f, 0, false) & 0xff); }
    }
}
}

__global__ void __launch_bounds__(NTHREADS, 2) hybrid_fwd(Args args) {
    extern __shared__ __attribute__((aligned(16))) unsigned char lds_raw[];
    LAS unsigned char* lds = (LAS unsigned char*)lds_raw;
    const int wv_ = __builtin_amdgcn_readfirstlane((int)threadIdx.x >> 6); const int bid = blockIdx.x, nb = gridDim.x;
    unsigned char* ws = args.ws;
    { const int tid = TIDX; if (tid < 4) ((LAS unsigned*)(lds + LDS_BARW))[tid] = 0u; }
    __syncthreads();
    XcdBarrier bar; bar.bar = (unsigned*)(ws + WS_CTL); bar.x = 0; bar.st = nullptr;
    const int lo = args.ph_lo, hi = args.ph_hi;
    if (hi - lo > 1) bar = xcd_barrier_post((unsigned*)(ws + WS_CTL) + args.bar_idx * XCD_BAR_WORDS, (volatile LAS unsigned*)(lds + LDS_BARW), wv_);
#ifndef PHASE_MASK
#define PHASE_MASK 0x7ff
#endif
#define IN(k) (((PHASE_MASK >> (k)) & 1) && lo <= (k) && (k) < hi)
#define SEAM(k) do { if (IN(k) && IN((k) + 1)) xcd_barrier(bar, wv_); } while (0)
    float* mod = (float*)(ws + WS_MOD);
    bf16_t* H = (bf16_t*)(ws + WS_H);
    bf16_t* QKV = (bf16_t*)(ws + WS_QKV);
    unsigned char* GD = ws + WS_QKV;

    if (IN(0)) { p0_prologue(args, lds, bid, nb, wv_); }
    SEAM(0);
    if (IN(1)) { norm_phase<true, true, false>(karg_in(0), karg_in(4), mod + 0 * DM, mod + 1 * DM, nullptr, ws + WS_H8, (const bf16_t*)(ws + WS_WFZT), karg_in(6), (float*)(ws + WS_LOGF), lds, bid, nb, wv_); }
    SEAM(1);
    if (IN(2)) {
        att2::build_gtab(karg_in(11), (bf16_t*)(ws + WS_GTAB), bid, nb, wv_);
        cumsum_phase((const float*)(ws + WS_LOGF), (float*)(ws + WS_NB), lds + LDS_AUX, bid, nb, wv_);
        pg8::Gemm g{(const bf16_t*)(ws + WS_H8), (const bf16_t*)(ws + WS_WINT), NTOK, NQKV, DM}; pg8::StaticOrder S; S.init(NTOK, NQKV, nb, bid);
        pg8::EpiQKV E{QKV, karg_in(7), karg_in(8), karg_in(9), karg_in(10), (LAS float*)(lds + LDS_AUX), 0.015625f};
        pg8::gemm_phase<pg8::EpiQKV, pg8::StaticOrder, true, true, 1>(lds, g, S, E, wv_);
    }
    SEAM(2);
    if (IN(3)) { att2::attn_phase(QKV, (const float*)(ws + WS_NB), (const float*)(ws + WS_GTAB), karg_in(9), karg_in(10), ws + WS_H8, lds, bid, nb, wv_); }
    SEAM(3);
    if (IN(4)) {
        pg8::Gemm g{(const bf16_t*)(ws + WS_H8), (const bf16_t*)(ws + WS_WOT), NTOK, DM, DM}; pg8::StaticOrder S; S.init(NTOK, DM, nb, bid);
        pg8::EpiResid<false, true> E{karg_in(0), ws + WS_X1, mod + 2 * DM, 1.0f / 1024.0f};
        pg8::gemm_phase<pg8::EpiResid<false, true>, pg8::StaticOrder, true, true, 1>(lds, g, S, E, wv_);
    }
    SEAM(4);
    if (IN(5)) {
        norm_phase<false, true, true, false, true>(ws + WS_X1, karg_in(13), mod + 3 * DM, mod + 4 * DM, H, ws + WS_H8, nullptr, nullptr, nullptr, lds, bid, nb, wv_);
    }
    SEAM(5);
    if (IN(6)) {
        pg8::Gemm g{H, (const bf16_t*)(ws + WS_WCT), NTOK, NSC, DM}; pg8::StaticOrder S; S.init(NTOK, NSC, nb, bid);
        pg8::EpiScoreT E{(float*)(ws + WS_SC)};
        pg8::gemm_phase<pg8::EpiScoreT, pg8::StaticOrder, true, true>(lds, g, S, E, wv_);
    }
    SEAM(6);
    if (IN(7)) {
        { u32x4* z = (u32x4*)(ws + WS_PRE); const size_t n16 = (size_t)NTOK * 128 * 4 / 16;
          for (size_t i = (size_t)bid * NTHREADS + TIDX; i < n16; i += (size_t)nb * NTHREADS) z[i] = (u32x4){0u, 0u, 0u, 0u}; }
        peer::topk_phase((const float*)(ws + WS_SC), GD, (float*)(ws + WS_GATEC), (int*)(ws + WS_EC), lds, bid, nb, wv_);
    }
    SEAM(7);
    if (IN(8)) {
        pg8::Gemm g{(const bf16_t*)(ws + WS_H8), (const bf16_t*)(ws + WS_UB), NTOK, NEXP, DM}; pg8::StaticOrder S; S.init(NTOK, NEXP, nb, bid);
        pg8::EpiSlot E{GD, NEXP, 0.015625f, (float*)(ws + WS_PRE)};
        pg8::gemm_phase<pg8::EpiSlot, pg8::StaticOrder, true, true, 1>(lds, g, S, E, wv_);
    }
    SEAM(8);
    if (IN(9)) { peer::act_phase((const float*)(ws + WS_PRE), (const float*)(ws + WS_GATEC), (const int*)(ws + WS_EC), GD, bid, nb, wv_); }
    SEAM(9);
    if (IN(10)) {
        pg8::Gemm g{(const bf16_t*)GD, (const bf16_t*)(ws + WS_VT), NTOK, DM, NEXP}; pg8::StaticOrder S; S.init(NTOK, DM, nb, bid);
        pg8::EpiResid<true, false> E{ws + WS_X1, (float*)karg_in(19), mod + 5 * DM, 0.0625f};
        pg8::gemm_phase<pg8::EpiResid<true, false>, pg8::StaticOrder, true, true, 1, true>(lds, g, S, E, wv_);
    }
#undef IN
#undef SEAM
}

#if ATT_PROBE == 6
__global__ void __launch_bounds__(NTHREADS, 2) fox_probe(Args args) {
    extern __shared__ __attribute__((aligned(16))) unsigned char lds_raw2[];
    LAS unsigned char* lds = (LAS unsigned char*)lds_raw2;
    const int wv_ = __builtin_amdgcn_readfirstlane((int)threadIdx.x >> 6); unsigned char* ws = args.ws;
    att2::fox_part((const bf16_t*)(ws + WS_QKV), (const float*)(ws + WS_NB), args.in[9], args.in[10], ws + WS_SC, lds, blockIdx.x, gridDim.x, wv_, FOXDBG);
}
#endif
extern "C" void kernel_launch(void* const* d_in, const int* in_sizes, int n_in, void* d_out, int out_size, void* d_ws, size_t ws_size, hipStream_t stream) {
    static int grid = 0;
    if (grid == 0) {
        if (n_in != 19 || out_size != NTOK * DM || ws_size < WS_END) { fprintf(stderr, "kernel_launch: unexpected shapes (n_in %d, out %d, ws %zu < %zu)\n", n_in, out_size, ws_size, (size_t)WS_END); grid = -1; return; }
        int dev = 0, cus = 0, per_cu = 0;
        if (hipGetDevice(&dev) != hipSuccess || hipDeviceGetAttribute(&cus, hipDeviceAttributeMultiprocessorCount, dev) != hipSuccess) { grid = -1; return; }
        if (hipFuncSetAttribute((const void*)hybrid_fwd, hipFuncAttributeMaxDynamicSharedMemorySize, LDS_BYTES) != hipSuccess) { fprintf(stderr, "kernel_launch: hipFuncSetAttribute failed\n"); grid = -1; return; }
        if (hipOccupancyMaxActiveBlocksPerMultiprocessor(&per_cu, (const void*)hybrid_fwd, NTHREADS, LDS_BYTES) != hipSuccess || per_cu < 1) { fprintf(stderr, "kernel_launch: occupancy query says %d\n", per_cu); per_cu = 1; }
        (void)hipGetLastError();
        grid = cus;
    }
    if (grid < 0) return;
    (void)hipMemsetAsync((char*)d_ws + WS_CTL, 0, CTL_ZERO_BYTES, stream);
    Args a{};
    for (int i = 0; i < 19; ++i) a.in[i] = (const float*)d_in[i];
    a.out = (float*)d_out; a.ws = (unsigned char*)d_ws;
#ifndef PROBE_PHASES
#define PROBE_PHASES 0
#endif
    int start = 0, nl = 0;
    for (int k = 0; k < 11; ++k) if ((PROBE_PHASES >> k) & 1) {
        a.ph_lo = start; a.ph_hi = k + 1; a.bar_idx = (k + 1 - start > 1) ? nl++ : 0; hipLaunchKernelGGL(hybrid_fwd, dim3(grid), dim3(NTHREADS), LDS_BYTES, stream, a);
        a.ph_lo = k; a.ph_hi = k + 1; a.bar_idx = 0; hipLaunchKernelGGL(hybrid_fwd, dim3(grid), dim3(NTHREADS), LDS_BYTES, stream, a);
        start = k + 1; }
    if (start < 11) { a.ph_lo = start; a.ph_hi = 11; a.bar_idx = nl++ & 3; hipLaunchKernelGGL(hybrid_fwd, dim3(grid), dim3(NTHREADS), LDS_BYTES, stream, a); }
#if ATT_PROBE == 6
    { static bool once = false; if (!once) { once = true; (void)hipFuncSetAttribute((const void*)fox_probe, hipFuncAttributeMaxDynamicSharedMemorySize, LDS_BYTES); }
      a.pad = FOXDBG; hipLaunchKernelGGL(fox_probe, dim3(grid), dim3(NTHREADS), LDS_BYTES, stream, a); }
#endif
}
```
